# Optimizing an MI355X kernel written in HIP

```python
import math
import jax, jax.numpy as jnp
from jax import lax
import numpy as np

D_MODEL = 1024
BATCH = 8
SEQ = 4096
DEPTH = 1

CHUNK = 64
N_MEM = 256
Q_BLOCK = 128
SSM_WIDTH = D_MODEL // 2
SSM_GROUP = 16
SSM_GROUPS = SSM_WIDTH // SSM_GROUP
SSM_STATE = 64
DT_MIN = 1e-3
DT_MAX = 1e-1
DIFF_HEADS = 4
DIFF_HEAD_DIM = D_MODEL // 16
DIFF_QK = 2 * DIFF_HEADS * DIFF_HEAD_DIM
DIFF_V = DIFF_HEADS * 2 * DIFF_HEAD_DIM
MEM_HEADS = 4
MEM_HEAD_DIM = D_MODEL // 8
MEM_WIDTH = MEM_HEADS * MEM_HEAD_DIM
N_BRANCH = 3
REL_BUCKETS = 32
REL_MAX_DIST = 128
LN_EPS = 1e-5
RMS_EPS = 1e-5
NEG_INF = -1e30
DEEPNORM_ALPHA = (2.0 * DEPTH) ** 0.25
DEEPNORM_BETA = (8.0 * DEPTH) ** -0.25
SPLITS = [SSM_WIDTH, SSM_WIDTH, DIFF_QK, DIFF_QK, DIFF_V, DIFF_V, MEM_WIDTH, MEM_WIDTH, N_BRANCH * D_MODEL]
D_IN = SSM_WIDTH * 2 + DIFF_QK * 2 + DIFF_V * 2 + MEM_WIDTH * 2 + N_BRANCH * D_MODEL

kernel_name = "hybrid_s5_diffattn_memxattn_deepnorm"


def _split_points():
    pts, acc = [], 0
    for s in SPLITS[:-1]:
        acc += s
        pts.append(acc)
    return pts


def _layer_norm(h, g, b):
    hf = h.astype(jnp.float32)
    mu = jnp.mean(hf, axis=-1, keepdims=True)
    var = jnp.mean(jnp.square(hf - mu), axis=-1, keepdims=True)
    return ((hf - mu) * lax.rsqrt(var + LN_EPS) * g + b).astype(h.dtype)


def _t5_bucket(rel):
    half = REL_BUCKETS // 2
    max_exact = half // 2
    ret = jnp.where(rel > 0, half, 0)
    n = jnp.abs(rel)
    large = max_exact + (jnp.log(jnp.maximum(n, 1).astype(jnp.float32) / max_exact)
                         / math.log(REL_MAX_DIST / max_exact) * (half - max_exact)).astype(jnp.int32)
    large = jnp.minimum(large, half - 1)
    return ret + jnp.where(n < max_exact, n, large)


def _scan_op(e1, e2):
    a1, b1 = e1
    a2, b2 = e2
    return a2 * a1, a2 * b1 + b2


def _s5_branch(u, lam_re, lam_im, log_dt, b_re, b_im, c_re, c_im, d_skip, w_glu):
    bsz, seq, _ = u.shape
    uf = u.astype(jnp.float32)
    lam = lax.complex(lam_re.astype(jnp.float32), lam_im.astype(jnp.float32))
    dt = jnp.exp(log_dt.astype(jnp.float32))[:, None]
    lam_bar = jnp.exp(lam * dt)
    b = lax.complex(b_re.astype(jnp.float32), b_im.astype(jnp.float32))
    b_bar = ((lam_bar - 1.0) / lam)[..., None] * b
    ug = uf.reshape(bsz, seq, SSM_GROUPS, SSM_GROUP).astype(jnp.complex64)
    bu = jnp.einsum('bsgh,gph->bsgp', ug, b_bar)
    a = jnp.broadcast_to(lam_bar, (1, seq) + lam_bar.shape)
    _, states = lax.associative_scan(_scan_op, (a, bu), axis=1)
    c = lax.complex(c_re.astype(jnp.float32), c_im.astype(jnp.float32))
    y = jnp.real(jnp.einsum('bsgp,ghp->bsgh', states, c)).reshape(bsz, seq, SSM_WIDTH)
    y = jax.nn.gelu(y + d_skip.astype(jnp.float32) * uf)
    val, gate = jnp.split(y @ w_glu.astype(jnp.float32), 2, axis=-1)
    return (val * jax.nn.sigmoid(gate)).astype(u.dtype)


def _diff_attention(q, k, v, lambda_q1, lambda_k1, lambda_q2, lambda_k2, subln_w, rel_bias, lambda_init):
    bsz, seq, _ = q.shape
    scale = DIFF_HEAD_DIM ** -0.5
    q = q.reshape(bsz, seq, DIFF_HEADS, 2, DIFF_HEAD_DIM) * scale
    k = k.reshape(bsz, seq, DIFF_HEADS, 2, DIFF_HEAD_DIM)
    v = v.reshape(bsz, seq, DIFF_HEADS, 2 * DIFF_HEAD_DIM)
    lam = (jnp.exp(jnp.sum(lambda_q1.astype(jnp.float32) * lambda_k1.astype(jnp.float32)))
           - jnp.exp(jnp.sum(lambda_q2.astype(jnp.float32) * lambda_k2.astype(jnp.float32)))
           + lambda_init)
    dist = jnp.arange(-(seq - 1), seq)
    bias_d = rel_bias[_t5_bucket(dist)].astype(jnp.float32)
    n_blk = seq // Q_BLOCK
    qb = q.reshape(bsz, n_blk, Q_BLOCK, DIFF_HEADS, 2, DIFF_HEAD_DIM).transpose(1, 0, 2, 3, 4, 5)
    kpos = jnp.arange(seq)

    def attend(args):
        q_blk, blk = args
        qpos = blk * Q_BLOCK + jnp.arange(Q_BLOCK)
        s = jnp.einsum('bqhcd,bkhcd->bhcqk', q_blk, k).astype(jnp.float32)
        bias = bias_d[kpos[None, :] - qpos[:, None] + seq - 1]
        s = s + bias.transpose(2, 0, 1)[None, :, None]
        allowed = (kpos[None, :] // CHUNK) <= (qpos[:, None] // CHUNK)
        p = jax.nn.softmax(jnp.where(allowed, s, NEG_INF), axis=-1)
        a = p[:, :, 0] - lam * p[:, :, 1]
        return jnp.einsum('bhqk,bkhe->bqhe', a.astype(v.dtype), v)

    o = lax.map(attend, (qb, jnp.arange(n_blk)))
    o = o.transpose(1, 0, 2, 3, 4).reshape(bsz, seq, DIFF_HEADS, 2 * DIFF_HEAD_DIM).astype(jnp.float32)
    o = o * lax.rsqrt(jnp.mean(jnp.square(o), axis=-1, keepdims=True) + RMS_EPS) * subln_w
    o = o * (1.0 - lambda_init)
    return o.reshape(bsz, seq, DIFF_V)


def _memory_attention(q, mk, mv):
    bsz, seq, _ = q.shape
    n_mem = mk.shape[1]
    q = q.reshape(bsz, seq, MEM_HEADS, MEM_HEAD_DIM) * (MEM_HEAD_DIM ** -0.5)
    mk = mk.reshape(bsz, n_mem, MEM_HEADS, MEM_HEAD_DIM)
    mv = mv.reshape(bsz, n_mem, MEM_HEADS, MEM_HEAD_DIM)
    s = jnp.einsum('bshd,bmhd->bhsm', q, mk).astype(jnp.float32)
    p = jax.nn.softmax(s, axis=-1)
    o = jnp.einsum('bhsm,bmhd->bshd', p.astype(mv.dtype), mv)
    return o.reshape(bsz, seq, MEM_WIDTH)


def setup_inputs(seed: int = 0) -> dict:
    key = jax.random.key(seed)
    ks = jax.random.split(key, 32)
    nrm = jax.random.normal
    f32 = jnp.float32
    pts = _split_points()
    x = nrm(ks[0], (BATCH, SEQ, D_MODEL), f32)
    mem = nrm(ks[1], (BATCH, N_MEM, D_MODEL), f32)
    w_in = nrm(ks[2], (DEPTH, D_MODEL, D_IN), f32) * D_MODEL ** -0.5
    w_in = w_in.at[:, :, pts[3]:pts[4]].multiply(DEEPNORM_BETA)
    lam_re = -0.5 + 0.01 * nrm(ks[3], (DEPTH, SSM_GROUPS, SSM_STATE), f32)
    lam_im = (jnp.pi * jnp.arange(SSM_STATE, dtype=f32))[None, None, :] + 0.01 * nrm(ks[4], (DEPTH, SSM_GROUPS, SSM_STATE), f32)
    log_dt = jax.random.uniform(ks[5], (DEPTH, SSM_GROUPS), f32, math.log(DT_MIN), math.log(DT_MAX))
    b_re = nrm(ks[6], (DEPTH, SSM_GROUPS, SSM_STATE, SSM_GROUP), f32) * (2.0 * SSM_GROUP) ** -0.5
    b_im = nrm(ks[7], (DEPTH, SSM_GROUPS, SSM_STATE, SSM_GROUP), f32) * (2.0 * SSM_GROUP) ** -0.5
    c_re = nrm(ks[8], (DEPTH, SSM_GROUPS, SSM_GROUP, SSM_STATE), f32) * SSM_STATE ** -0.5
    c_im = nrm(ks[9], (DEPTH, SSM_GROUPS, SSM_GROUP, SSM_STATE), f32) * SSM_STATE ** -0.5
    d_skip = nrm(ks[10], (DEPTH, SSM_WIDTH), f32)
    w_glu = nrm(ks[11], (DEPTH, SSM_WIDTH, 2 * SSM_WIDTH), f32) * SSM_WIDTH ** -0.5
    lambda_q1 = 0.1 * nrm(ks[12], (DEPTH, DIFF_HEAD_DIM), f32)
    lambda_k1 = 0.1 * nrm(ks[13], (DEPTH, DIFF_HEAD_DIM), f32)
    lambda_q2 = 0.1 * nrm(ks[14], (DEPTH, DIFF_HEAD_DIM), f32)
    lambda_k2 = 0.1 * nrm(ks[15], (DEPTH, DIFF_HEAD_DIM), f32)
    subln_w = 1.0 + 0.01 * nrm(ks[16], (DEPTH, 2 * DIFF_HEAD_DIM), f32)
    rel_bias = 0.5 * nrm(ks[17], (REL_BUCKETS, DIFF_HEADS), f32)
    w_mem_kv = nrm(ks[18], (DEPTH, D_MODEL, 2 * MEM_WIDTH), f32) * D_MODEL ** -0.5
    w_mem_kv = w_mem_kv.at[:, :, MEM_WIDTH:].multiply(DEEPNORM_BETA)
    w_br_ssm = nrm(ks[19], (DEPTH, SSM_WIDTH, D_MODEL), f32) * SSM_WIDTH ** -0.5 * DEEPNORM_BETA
    w_br_diff = nrm(ks[20], (DEPTH, DIFF_V, D_MODEL), f32) * DIFF_V ** -0.5 * DEEPNORM_BETA
    w_br_mem = nrm(ks[21], (DEPTH, MEM_WIDTH, D_MODEL), f32) * MEM_WIDTH ** -0.5 * DEEPNORM_BETA
    w_out = nrm(ks[22], (DEPTH, D_MODEL, D_MODEL), f32) * D_MODEL ** -0.5 * DEEPNORM_BETA
    ln_g = 1.0 + 0.01 * nrm(ks[23], (DEPTH, D_MODEL), f32)
    ln_b = 0.01 * nrm(ks[24], (DEPTH, D_MODEL), f32)
    return {"x": x, "mem": mem, "w_in": w_in, "lam_re": lam_re, "lam_im": lam_im, "log_dt": log_dt,
            "b_re": b_re, "b_im": b_im, "c_re": c_re, "c_im": c_im, "d_skip": d_skip, "w_glu": w_glu,
            "lambda_q1": lambda_q1, "lambda_k1": lambda_k1, "lambda_q2": lambda_q2, "lambda_k2": lambda_k2,
            "subln_w": subln_w, "rel_bias": rel_bias, "w_mem_kv": w_mem_kv, "w_br_ssm": w_br_ssm,
            "w_br_diff": w_br_diff, "w_br_mem": w_br_mem, "w_out": w_out, "ln_g": ln_g, "ln_b": ln_b}


def reference(x, mem, w_in, lam_re, lam_im, log_dt, b_re, b_im, c_re, c_im, d_skip, w_glu,
              lambda_q1, lambda_k1, lambda_q2, lambda_k2, subln_w, rel_bias, w_mem_kv,
              w_br_ssm, w_br_diff, w_br_mem, w_out, ln_g, ln_b):
    bsz, seq, _ = x.shape
    pts = _split_points()
    h = x
    for layer in range(DEPTH):
        lambda_init = 0.8 - 0.6 * math.exp(-0.3 * layer)
        proj = h @ w_in[layer]
        u, z_ssm, dq, dk, dv, z_diff, mq, z_mem, gates = jnp.split(proj, pts, axis=-1)
        y_ssm = _s5_branch(u, lam_re[layer], lam_im[layer], log_dt[layer], b_re[layer], b_im[layer],
                           c_re[layer], c_im[layer], d_skip[layer], w_glu[layer])
        y_ssm = (y_ssm * jax.nn.silu(z_ssm)).astype(h.dtype)
        y_diff = _diff_attention(dq, dk, dv, lambda_q1[layer], lambda_k1[layer], lambda_q2[layer],
                                 lambda_k2[layer], subln_w[layer], rel_bias, lambda_init)
        y_diff = (y_diff * jax.nn.silu(z_diff.astype(jnp.float32))).astype(h.dtype)
        mk, mv = jnp.split(mem @ w_mem_kv[layer], 2, axis=-1)
        y_mem = (_memory_attention(mq, mk, mv) * jax.nn.silu(z_mem)).astype(h.dtype)
        g = jax.nn.sigmoid(gates.astype(jnp.float32)).reshape(bsz, seq, N_BRANCH, D_MODEL)
        merged = (g[:, :, 0] * (y_ssm @ w_br_ssm[layer])
                  + g[:, :, 1] * (y_diff @ w_br_diff[layer])
                  + g[:, :, 2] * (y_mem @ w_br_mem[layer]))
        out = merged.astype(h.dtype) @ w_out[layer]
        h = _layer_norm(DEEPNORM_ALPHA * h + out, ln_g[layer], ln_b[layer])
    return h
```

```cpp
#include <hip/hip_runtime.h>
#include <hip/hip_cooperative_groups.h>
#include <cstdio>
#include <cstdint>
#include <cmath>

#ifndef REP_MASK
#define REP_MASK 0
#endif
#ifndef ONE_LAUNCH
#define ONE_LAUNCH 1
#endif
#ifndef USE_NAIVE_ATTN
#define USE_NAIVE_ATTN 0
#endif
#ifndef USE_NAIVE_S5
#define USE_NAIVE_S5 0
#endif
typedef unsigned short bf16;
typedef unsigned v4u __attribute__((ext_vector_type(4)));
typedef float f32x4 __attribute__((ext_vector_type(4)));

constexpr int NB = 8, SEQ = 4096, DM = 1024, T = NB * SEQ, DIN = 7168, NMEM = 256;
constexpr int NG = 32, NP = 64, NH16 = 16, CL = 64, NCOL = T / CL;
constexpr float LN_EPS = 1e-5f, RMS_EPS = 1e-5f, LOG2E = 1.4426950408889634f;
constexpr float ALPHA = 1.189207115002721f;
constexpr float LAMBDA_INIT = 0.2f;
constexpr float QS_DIFF = 0.125f * LOG2E, QS_MEM = 0.08838834764831845f * LOG2E;

constexpr size_t MiB = 1u << 20;
constexpr size_t WS_CTL = 0;
constexpr size_t WS_SC = 64 * 1024;
constexpr size_t WS_LP = 128 * 1024;
constexpr size_t WS_WINT = 1 * MiB, WS_WGLUT = 15 * MiB, WS_WMKVT = 16 * MiB, WS_WBRT = 18 * MiB, WS_WOUTT = 21 * MiB;
constexpr size_t WS_PROJ = 64 * MiB, SEGB = 32 * MiB;
constexpr size_t WS_UG = WS_PROJ, WS_ZS = WS_PROJ + SEGB, WS_DQ = WS_PROJ + 2 * SEGB, WS_DK = WS_PROJ + 3 * SEGB, WS_DV = WS_PROJ + 4 * SEGB,
                 WS_ZD = WS_PROJ + 5 * SEGB, WS_MQ = WS_PROJ + 6 * SEGB, WS_ZM = WS_PROJ + 7 * SEGB, WS_GT = WS_PROJ + 8 * SEGB;
constexpr size_t WS_YD = 24 * MiB;
constexpr size_t WS_YS = WS_UG;
constexpr size_t WS_MG = WS_DK;
constexpr size_t WS_END = 512 * MiB;
constexpr size_t DO_XB = 0, DO_VB = 0  , DO_YM = 32 * MiB  , DO_MEMB = 64 * MiB, DO_TGC = 68 * MiB, DO_WG = 70 * MiB, DO_GG = 78 * MiB,
                 DO_F = 87 * MiB, DO_HH = 95 * MiB, DO_MK = 103 * MiB, DO_MV = 105 * MiB;

struct Ctx {
    const float *x, *mem, *w_in, *lam_re, *lam_im, *log_dt, *b_re, *b_im, *c_re, *c_im, *d_skip, *w_glu, *lq1, *lk1, *lq2, *lk2, *subln, *rel_bias, *w_mem_kv,
        *w_br_ssm, *w_br_diff, *w_br_mem, *w_out, *ln_g, *ln_b;
    float* out; unsigned char* ws;
    int ph_lo, ph_hi, coop, pad;
};
#define WSP(T_, off) ((T_*)(c.ws + (off)))
#define DOP(T_, off) ((T_*)((unsigned char*)c.out + (off)))

__device__ __forceinline__ unsigned f2bf(float f) { unsigned u = __builtin_bit_cast(unsigned, f); return (u + 0x7fffu + ((u >> 16) & 1u)) >> 16; }
__device__ __forceinline__ float bf2f(bf16 h) { return __builtin_bit_cast(float, (unsigned)h << 16); }
__device__ __forceinline__ unsigned pk2(float lo, float hi) { return f2bf(lo) | (f2bf(hi) << 16); }
__device__ __forceinline__ float sigmoidf_(float v) { return 1.0f / (1.0f + __expf(-v)); }
__device__ __forceinline__ float siluf_(float v) { return v * sigmoidf_(v); }
__device__ __forceinline__ float gelu_tanh(float v) { const float u = 0.7978845608028654f * (v + 0.044715f * v * v * v); const float e = __expf(2.0f * u); const float th = 1.0f - 2.0f / (e + 1.0f); return 0.5f * v * (1.0f + th); }

__device__ __forceinline__ int t5_bucket(int rel) {
    const int n = rel < 0 ? -rel : rel; int b;
    if (n < 8) b = n; else b = 8 + (n >= 12) + (n >= 16) + (n >= 23) + (n >= 32) + (n >= 46) + (n >= 64) + (n >= 91);
    return b + (rel > 0 ? 16 : 0);
}

__device__ __forceinline__ void p0_transpose_item(const float* W, int ldw, bf16* WT, int ldt, int k0, int n0src, int n0dst, int k0dst, float* scr, int lane) {
#pragma unroll 8
    for (int i = 0; i < 32; ++i) { const int kk = 2 * i + (lane >> 5); scr[kk * 33 + (lane & 31)] = W[(size_t)(k0 + kk) * ldw + n0src + (lane & 31)]; }
    __builtin_amdgcn_s_waitcnt(0); asm volatile("" ::: "memory");
    const int cch = lane & 7;
#pragma unroll
    for (int j = 0; j < 4; ++j) { const int n = (lane >> 3) + 8 * j; const float* s = scr + (8 * cch) * 33 + n;
        v4u o; o.x = pk2(s[0 * 33], s[1 * 33]); o.y = pk2(s[2 * 33], s[3 * 33]); o.z = pk2(s[4 * 33], s[5 * 33]); o.w = pk2(s[6 * 33], s[7 * 33]);
        *(v4u*)(WT + (size_t)(n0dst + n) * ldt + k0dst + k0 + 8 * cch) = o; }
    __builtin_amdgcn_s_waitcnt(0); asm volatile("" ::: "memory");
}
struct cplx { double re, im; };
__device__ __forceinline__ cplx cmul(cplx a, cplx b) { return {a.re * b.re - a.im * b.im, a.re * b.im + a.im * b.re}; }

__device__ __forceinline__ void p0_prologue(const Ctx& c, int gw, int NGW, int lane, float* scr) {
    {
        constexpr int I_IN = 16 * 224, I_GLU = 8 * 32, I_MKV = 16 * 32, I_BR = 8 * 32, I_OUT = 16 * 32;
        constexpr int NIT = I_IN + I_GLU + I_MKV + 3 * I_BR + I_OUT;
        for (int it = gw; it < NIT; it += NGW) {
            int r = it;
            if (r < I_IN) { const int kb = r / 224, nb = r % 224; p0_transpose_item(c.w_in, DIN, WSP(bf16, WS_WINT), 1024, 64 * kb, 32 * nb, 32 * nb, 0, scr, lane); continue; } r -= I_IN;
            if (r < I_GLU) { const int kb = r / 32, nb = r % 32;
                const int nd = 32 * nb, pn = nd >> 8, bj = (nd >> 7) & 1, j = nd & 127;
                p0_transpose_item(c.w_glu, 1024, WSP(bf16, WS_WGLUT), 512, 64 * kb, 512 * bj + 128 * pn + j, nd, 0, scr, lane); continue; } r -= I_GLU;
            if (r < I_MKV) { const int kb = r / 32, nb = r % 32; p0_transpose_item(c.w_mem_kv, 1024, WSP(bf16, WS_WMKVT), 1024, 64 * kb, 32 * nb, 32 * nb, 0, scr, lane); continue; } r -= I_MKV;
            if (r < 3 * I_BR) { const int s = r / I_BR, rr = r % I_BR, kb = rr / 32, nb = rr % 32; const float* W = s == 0 ? c.w_br_ssm : (s == 1 ? c.w_br_diff : c.w_br_mem);
                p0_transpose_item(W, 1024, WSP(bf16, WS_WBRT), 1536, 64 * kb, 32 * nb, 32 * nb, 512 * s, scr, lane); continue; } r -= 3 * I_BR;
            { const int kb = r / 32, nb = r % 32; p0_transpose_item(c.w_out, 1024, WSP(bf16, WS_WOUTT), 1024, 64 * kb, 32 * nb, 32 * nb, 0, scr, lane); }
        }
    }
    {
        const size_t n8 = (size_t)T * DM / 8; bf16* XB = DOP(bf16, DO_XB);
        for (size_t i = (size_t)gw * 64 + lane; i < n8; i += (size_t)NGW * 64) { const f32x4 a = ((const f32x4*)c.x)[2 * i], b = ((const f32x4*)c.x)[2 * i + 1];
            v4u o; o.x = pk2(a.x, a.y); o.y = pk2(a.z, a.w); o.z = pk2(b.x, b.y); o.w = pk2(b.z, b.w); ((v4u*)XB)[i] = o; }
        const size_t m8 = (size_t)NB * NMEM * DM / 8; bf16* MB = DOP(bf16, DO_MEMB);
        for (size_t i = (size_t)gw * 64 + lane; i < m8; i += (size_t)NGW * 64) { const f32x4 a = ((const f32x4*)c.mem)[2 * i], b = ((const f32x4*)c.mem)[2 * i + 1];
            v4u o; o.x = pk2(a.x, a.y); o.y = pk2(a.z, a.w); o.z = pk2(b.x, b.y); o.w = pk2(b.z, b.w); ((v4u*)MB)[i] = o; }
    }
    {
        bf16* TGC = DOP(bf16, DO_TGC); bf16* WG = DOP(bf16, DO_WG); bf16* GG = DOP(bf16, DO_GG); float* LP = WSP(float, WS_LP);
        float* m1re = scr; float* m1im = scr + 1024;
        for (int it = gw; it < NG * 65; it += NGW) {
            const int g = it / 65, d = it % 65, p = lane;
            const double dt = exp((double)c.log_dt[g]); const double lr = c.lam_re[g * NP + p], li = c.lam_im[g * NP + p];
            const double er = exp(lr * dt * d); const cplx E = {er * cos(li * dt * d), er * sin(li * dt * d)};
            if (d <= 63) {
                const double e1 = exp(lr * dt); const cplx lb = {e1 * cos(li * dt), e1 * sin(li * dt)};
                const double den = lr * lr + li * li; const cplx num = {lb.re - 1.0, lb.im}; const cplx coef = {(num.re * lr + num.im * li) / den, (num.im * lr - num.re * li) / den};
                const cplx EC = cmul(E, coef);
#pragma unroll
                for (int h = 0; h < 16; ++h) { const cplx bb = {c.b_re[(g * NP + p) * 16 + h], c.b_im[(g * NP + p) * 16 + h]}; const cplx m = cmul(EC, bb);
                    m1re[p * 16 + h] = (float)m.re; m1im[p * 16 + h] = (float)m.im;
                    const int j = 63 - d; WG[((size_t)g * 128 + p) * 1024 + j * 16 + h] = (bf16)f2bf((float)m.re); WG[((size_t)g * 128 + 64 + p) * 1024 + j * 16 + h] = (bf16)f2bf((float)m.im); }
                __builtin_amdgcn_s_waitcnt(0); asm volatile("" ::: "memory");
                const int h = lane >> 2, h0 = 4 * (lane & 3); float a0 = 0.f, a1 = 0.f, a2 = 0.f, a3 = 0.f;
                for (int pp = 0; pp < NP; ++pp) { const float cr = c.c_re[(g * 16 + h) * NP + pp], ci = c.c_im[(g * 16 + h) * NP + pp];
                    a0 += cr * m1re[pp * 16 + h0] - ci * m1im[pp * 16 + h0]; a1 += cr * m1re[pp * 16 + h0 + 1] - ci * m1im[pp * 16 + h0 + 1];
                    a2 += cr * m1re[pp * 16 + h0 + 2] - ci * m1im[pp * 16 + h0 + 2]; a3 += cr * m1re[pp * 16 + h0 + 3] - ci * m1im[pp * 16 + h0 + 3]; }
                bf16* dst = TGC + (((size_t)g * 16 + h) * 127 + (63 - d)) * 16 + h0;
                dst[0] = (bf16)f2bf(a0); dst[1] = (bf16)f2bf(a1); dst[2] = (bf16)f2bf(a2); dst[3] = (bf16)f2bf(a3);
                __builtin_amdgcn_s_waitcnt(0); asm volatile("" ::: "memory");
            }
            if (d >= 1) { const int i = d - 1;
#pragma unroll
                for (int h = 0; h < 16; ++h) { const cplx cc = {c.c_re[(g * 16 + h) * NP + p], c.c_im[(g * 16 + h) * NP + p]}; const cplx m = cmul(cc, E);
                    GG[((size_t)g * 1024 + i * 16 + h) * 128 + p] = (bf16)f2bf((float)m.re); GG[((size_t)g * 1024 + i * 16 + h) * 128 + 64 + p] = (bf16)f2bf((float)(-m.im)); } }
            if (d == 64) { LP[(g * NP + p) * 2] = (float)E.re; LP[(g * NP + p) * 2 + 1] = (float)E.im; }
        }
        for (int i = gw * 64 + lane; i < NG * 16 * 63 * 16; i += NGW * 64) { const int hh = i & 15, m = 64 + (i >> 4) % 63, gh = (i >> 4) / 63; TGC[((size_t)gh * 127 + m) * 16 + hh] = 0; }
        for (int i = gw * 64 + lane; i < 4096; i += NGW * 64) GG[(size_t)NG * 1024 * 128 + i] = 0;
    }
    if (gw == 0) {
        float a = c.lq1[lane] * c.lk1[lane], b = c.lq2[lane] * c.lk2[lane];
        for (int o = 1; o < 64; o <<= 1) { a += __shfl_xor(a, o); b += __shfl_xor(b, o); }
        float* SC = WSP(float, WS_SC);
        if (lane == 0) SC[0] = expf(a) - expf(b) + LAMBDA_INIT;
        for (int i = lane; i < 4 * 256; i += 64) { const int h = i >> 8, rel = (i & 255) - 191; SC[256 + i] = c.rel_bias[t5_bucket(rel) * 4 + h] * LOG2E; }
    }
}
__global__ void __launch_bounds__(512) k_p0(Ctx c) {
    extern __shared__ __attribute__((aligned(16))) unsigned char lds[];
    const int lane = threadIdx.x & 63, wave = threadIdx.x >> 6;
    p0_prologue(c, blockIdx.x * 8 + wave, gridDim.x * 8, lane, (float*)(lds + wave * 16384));
}

__device__ __forceinline__ void p1_store(const Ctx& c, int row, int col, float v) {
    const int seg = col >> 9, cc = col & 511;
    if (seg >= 8) { WSP(bf16, WS_GT)[(size_t)row * 3072 + (col - 4096)] = (bf16)f2bf(sigmoidf_(v)); return; }
    if (seg == 0) { WSP(bf16, WS_UG)[(((size_t)(cc >> 4) * NCOL + (row >> 6)) * 64 + (row & 63)) * 16 + (cc & 15)] = (bf16)f2bf(v); return; }
    float o = v;
    if (seg == 1 || seg == 5 || seg == 7) o = siluf_(v); else if (seg == 2) o = v * QS_DIFF; else if (seg == 6) o = v * QS_MEM;
    WSP(bf16, WS_PROJ + (size_t)seg * SEGB)[(size_t)row * 512 + cc] = (bf16)f2bf(o);
}
enum { NM_P1 = 0, NM_MKV = 1, NM_GLU = 2, NM_MERGE = 3, NM_OUT = 4 };
template <int MODE> __global__ void __launch_bounds__(256) nk_gemm(Ctx c, const bf16* A, int lda, const bf16* Bt, int ldb, int K, int nseg) {
    __shared__ float As[64][33], Bs[64][33];
    const int tid = threadIdx.x, tx = tid & 15, ty = tid >> 4, row0 = blockIdx.y * 64, col0 = blockIdx.x * 64;
    float tot[4][4] = {};
    for (int seg = 0; seg < nseg; ++seg) {
        float acc[4][4] = {};
        const bf16* Aseg = A; int koff = 0;
        if (MODE == NM_MERGE) { Aseg = seg == 0 ? WSP(bf16, WS_YS) : (seg == 1 ? WSP(bf16, WS_YD) : DOP(bf16, DO_YM)); koff = 512 * seg; }
        for (int k0 = 0; k0 < K; k0 += 32) {
            for (int i = tid; i < 64 * 32; i += 256) { const int r = i >> 5, kk = i & 31; As[r][kk] = bf2f(Aseg[(size_t)(row0 + r) * lda + k0 + kk]); Bs[r][kk] = bf2f(Bt[(size_t)(col0 + r) * ldb + koff + k0 + kk]); }
            __syncthreads();
#pragma unroll 8
            for (int kk = 0; kk < 32; ++kk) {
                float a[4], b[4];
#pragma unroll
                for (int i = 0; i < 4; ++i) { a[i] = As[ty * 4 + i][kk]; b[i] = Bs[tx * 4 + i][kk]; }
#pragma unroll
                for (int i = 0; i < 4; ++i)
#pragma unroll
                    for (int j = 0; j < 4; ++j) acc[i][j] += a[i] * b[j];
            }
            __syncthreads();
        }
#pragma unroll
        for (int i = 0; i < 4; ++i)
#pragma unroll
            for (int j = 0; j < 4; ++j) { const int row = row0 + ty * 4 + i, col = col0 + tx * 4 + j;
                if (MODE == NM_MERGE) tot[i][j] += acc[i][j] * bf2f(WSP(bf16, WS_GT)[(size_t)row * 3072 + seg * 1024 + col]); else tot[i][j] = acc[i][j]; }
    }
#pragma unroll
    for (int i = 0; i < 4; ++i)
#pragma unroll
        for (int j = 0; j < 4; ++j) {
            const int row = row0 + ty * 4 + i, col = col0 + tx * 4 + j; const float v = tot[i][j];
            if (MODE == NM_P1) p1_store(c, row, col, v);
            else if (MODE == NM_MKV) { if (col < 512) DOP(bf16, DO_MK)[(size_t)row * 512 + col] = (bf16)f2bf(v); else DOP(bf16, DO_MV)[(size_t)row * 512 + col - 512] = (bf16)f2bf(v); }
            else if (MODE == NM_MERGE) WSP(bf16, WS_MG)[(size_t)row * 1024 + col] = (bf16)f2bf(v);
            else if (MODE == NM_OUT) c.out[(size_t)row * 1024 + col] = ALPHA * c.x[(size_t)row * 1024 + col] + v;
        }
}
__global__ void __launch_bounds__(256) nk_glu(Ctx c) {
    __shared__ float As[64][33], Bv[64][33], Bg[64][33];
    const int tid = threadIdx.x, tx = tid & 15, ty = tid >> 4, row0 = blockIdx.y * 64, ch0 = blockIdx.x * 64;
    const bf16* A = DOP(bf16, DO_VB); const bf16* Bt = WSP(bf16, WS_WGLUT);
    const int nv0 = 256 * (ch0 >> 7) + (ch0 & 127), ng0 = nv0 + 128;
    float av[4][4] = {}, ag[4][4] = {};
    for (int k0 = 0; k0 < 512; k0 += 32) {
        for (int i = tid; i < 64 * 32; i += 256) { const int r = i >> 5, kk = i & 31; As[r][kk] = bf2f(A[(size_t)(row0 + r) * 512 + k0 + kk]);
            Bv[r][kk] = bf2f(Bt[(size_t)(nv0 + r) * 512 + k0 + kk]); Bg[r][kk] = bf2f(Bt[(size_t)(ng0 + r) * 512 + k0 + kk]); }
        __syncthreads();
        for (int kk = 0; kk < 32; ++kk) {
            float a[4], b[4], g[4];
#pragma unroll
            for (int i = 0; i < 4; ++i) { a[i] = As[ty * 4 + i][kk]; b[i] = Bv[tx * 4 + i][kk]; g[i] = Bg[tx * 4 + i][kk]; }
#pragma unroll
            for (int i = 0; i < 4; ++i)
#pragma unroll
                for (int j = 0; j < 4; ++j) { av[i][j] += a[i] * b[j]; ag[i][j] += a[i] * g[j]; }
        }
        __syncthreads();
    }
#pragma unroll
    for (int i = 0; i < 4; ++i)
#pragma unroll
        for (int j = 0; j < 4; ++j) { const int row = row0 + ty * 4 + i, ch = ch0 + tx * 4 + j; const size_t off = (size_t)row * 512 + ch;
            WSP(bf16, WS_YS)[off] = (bf16)f2bf(av[i][j] * sigmoidf_(ag[i][j]) * bf2f(WSP(bf16, WS_ZS)[off])); }
}
__global__ void __launch_bounds__(64) nk_s5(Ctx c) {
    __shared__ float sm[16][65];
    const int b = blockIdx.x / NG, g = blockIdx.x % NG, p = threadIdx.x, lane = p;
    const float dt = expf(c.log_dt[g]), lr = c.lam_re[g * NP + p], li = c.lam_im[g * NP + p];
    const float e1 = expf(lr * dt), lbr = e1 * cosf(li * dt), lbi = e1 * sinf(li * dt);
    const float den = lr * lr + li * li, nr = lbr - 1.0f, ni = lbi, cfr = (nr * lr + ni * li) / den, cfi = (ni * lr - nr * li) / den;
    float Br[16], Bi[16], Cr[16], Ci[16];
#pragma unroll
    for (int h = 0; h < 16; ++h) { const float br = c.b_re[(g * NP + p) * 16 + h], bi = c.b_im[(g * NP + p) * 16 + h]; Br[h] = cfr * br - cfi * bi; Bi[h] = cfr * bi + cfi * br;
        Cr[h] = c.c_re[(g * 16 + h) * NP + p]; Ci[h] = c.c_im[(g * 16 + h) * NP + p]; }
    const bf16* UG = WSP(bf16, WS_UG); bf16* VB = DOP(bf16, DO_VB);
    float sr = 0.f, si = 0.f;
    const int hq = lane >> 2, q = lane & 3; const float dsk = c.d_skip[g * 16 + hq];
    for (int t = 0; t < SEQ; ++t) {
        const bf16* up = UG + (((size_t)g * NCOL + (b * 64 + (t >> 6))) * 64 + (t & 63)) * 16;
        float u[16];
#pragma unroll
        for (int h = 0; h < 16; ++h) u[h] = bf2f(up[h]);
        float bur = 0.f, bui = 0.f;
#pragma unroll
        for (int h = 0; h < 16; ++h) { bur += Br[h] * u[h]; bui += Bi[h] * u[h]; }
        const float nsr = lbr * sr - lbi * si + bur, nsi = lbr * si + lbi * sr + bui; sr = nsr; si = nsi;
#pragma unroll
        for (int h = 0; h < 16; ++h) sm[h][p] = Cr[h] * sr - Ci[h] * si;
        __builtin_amdgcn_s_waitcnt(0); asm volatile("" ::: "memory");
        float y = 0.f;
#pragma unroll
        for (int k = 0; k < 16; ++k) y += sm[hq][q * 16 + k];
        y += __shfl_xor(y, 1); y += __shfl_xor(y, 2);
        if (q == 0) VB[(size_t)(b * SEQ + t) * 512 + g * 16 + hq] = (bf16)f2bf(gelu_tanh(y + dsk * u[hq]));
        __builtin_amdgcn_s_waitcnt(0); asm volatile("" ::: "memory");
    }
}
template <bool DIFF> __global__ void __launch_bounds__(256) nk_attn(Ctx c) {
    extern __shared__ __attribute__((aligned(16))) unsigned char lds[];
    float* Qs = (float*)lds;
    float* Ks = Qs + 64 * 129;
    float* Vs = Ks + 32 * 129;
    float* Ps = Vs + 32 * 132;
    const int tid = threadIdx.x, row = tid >> 2, kq = tid & 3;
    const int qc = blockIdx.x & 63, h = (blockIdx.x >> 6) & 3, b = blockIdx.x >> 8;
    const int q0 = qc * 64; const size_t tok0 = (size_t)b * SEQ + q0;
    bf16* Qg = WSP(bf16, DIFF ? WS_DQ : WS_MQ); const bf16* Kg = DIFF ? WSP(bf16, WS_DK) : DOP(bf16, DO_MK); const bf16* Vg = DIFF ? WSP(bf16, WS_DV) : DOP(bf16, DO_MV);
    const size_t kbase = DIFF ? (size_t)b * SEQ : (size_t)b * NMEM;
    const float* BT = WSP(float, WS_SC) + 256 + h * 256;
    for (int i = tid; i < 64 * 128; i += 256) Qs[(i >> 7) * 129 + (i & 127)] = bf2f(Qg[(tok0 + (i >> 7)) * 512 + h * 128 + (i & 127)]);
    constexpr int NMAP = DIFF ? 2 : 1, DQK = DIFF ? 64 : 128;
    float m[NMAP], l[NMAP], o[NMAP][32];
#pragma unroll
    for (int mp = 0; mp < NMAP; ++mp) { m[mp] = -1e30f; l[mp] = 0.f;
#pragma unroll
        for (int i = 0; i < 32; ++i) o[mp][i] = 0.f; }
    const int ntile = DIFF ? 2 * (qc + 1) : NMEM / 32;
    for (int kt = 0; kt < ntile; ++kt) {
        __syncthreads();
        for (int i = tid; i < 32 * 128; i += 256) { const size_t r = kbase + kt * 32 + (i >> 7); Ks[(i >> 7) * 129 + (i & 127)] = bf2f(Kg[r * 512 + h * 128 + (i & 127)]); Vs[(i >> 7) * 132 + ((i & 127) >> 5) * 33 + (i & 31)] = bf2f(Vg[r * 512 + h * 128 + (i & 127)]); }
        __syncthreads();
#pragma unroll
        for (int mp = 0; mp < NMAP; ++mp) {
            float s[8]; float mx = -1e30f;
#pragma unroll
            for (int j = 0; j < 8; ++j) { const int kk = kq * 8 + j; float a = 0.f;
                for (int d = 0; d < DQK; ++d) a += Qs[row * 129 + mp * DQK + d] * Ks[kk * 129 + mp * DQK + d];
                if (DIFF) { const int rel = (kt * 32 + kk) - (q0 + row); a += rel >= -191 ? BT[rel + 191] : BT[0]; }
                s[j] = a; mx = fmaxf(mx, a); }
            mx = fmaxf(mx, __shfl_xor(mx, 1)); mx = fmaxf(mx, __shfl_xor(mx, 2));
            const float mn = fmaxf(m[mp], mx), al = exp2f(m[mp] - mn); m[mp] = mn; float ps = 0.f;
#pragma unroll
            for (int j = 0; j < 8; ++j) { const float pv = exp2f(s[j] - mn); ps += pv; Ps[(mp * 64 + row) * 33 + kq * 8 + j] = pv; }
            ps += __shfl_xor(ps, 1); ps += __shfl_xor(ps, 2);
            l[mp] = l[mp] * al + ps;
#pragma unroll
            for (int i = 0; i < 32; ++i) o[mp][i] *= al;
        }
        __syncthreads();
#pragma unroll
        for (int mp = 0; mp < NMAP; ++mp)
            for (int kk = 0; kk < 32; ++kk) { const float pv = Ps[(mp * 64 + row) * 33 + kk];
#pragma unroll
                for (int i = 0; i < 32; ++i) o[mp][i] += pv * Vs[kk * 132 + kq * 33 + i]; }
    }
    __syncthreads();
    if (DIFF) {
        const float lam = WSP(float, WS_SC)[0]; const float i0 = 1.0f / l[0], i1 = lam / l[NMAP - 1]; float ss = 0.f; float r[32];
#pragma unroll
        for (int i = 0; i < 32; ++i) { r[i] = o[0][i] * i0 - o[NMAP - 1][i] * i1; ss += r[i] * r[i]; }
        ss += __shfl_xor(ss, 1); ss += __shfl_xor(ss, 2);
        const float rs = rsqrtf(ss * (1.0f / 128.0f) + RMS_EPS) * (1.0f - LAMBDA_INIT);
#pragma unroll
        for (int i = 0; i < 32; ++i) { const int d = kq * 32 + i; const size_t idx = (tok0 + row) * 512 + h * 128 + d;
            WSP(bf16, WS_YD)[idx] = (bf16)f2bf(r[i] * rs * c.subln[d] * bf2f(WSP(bf16, WS_ZD)[idx])); }
    } else {
        const float i0 = 1.0f / l[0];
#pragma unroll
        for (int i = 0; i < 32; ++i) { const int d = kq * 32 + i; const size_t idx = (tok0 + row) * 512 + h * 128 + d;
            DOP(bf16, DO_YM)[idx] = (bf16)f2bf(o[0][i] * i0 * bf2f(WSP(bf16, WS_ZM)[idx])); }
    }
}
__device__ __forceinline__ void ln_rows(const Ctx& c, int gw, int NGW, int lane) {
    for (int r = gw; r < T; r += NGW) {
        f32x4* rp = (f32x4*)(c.out + (size_t)r * DM) + lane; f32x4 v[4]; float s = 0.f;
#pragma unroll
        for (int j = 0; j < 4; ++j) { v[j] = rp[64 * j]; s += (v[j].x + v[j].y) + (v[j].z + v[j].w); }
        for (int o = 1; o < 64; o <<= 1) s += __shfl_xor(s, o);
        const float mean = s * (1.0f / DM); float s2 = 0.f;
#pragma unroll
        for (int j = 0; j < 4; ++j) { v[j] = v[j] - mean; s2 += (v[j].x * v[j].x + v[j].y * v[j].y) + (v[j].z * v[j].z + v[j].w * v[j].w); }
        for (int o = 1; o < 64; o <<= 1) s2 += __shfl_xor(s2, o);
        const float rstd = rsqrtf(s2 * (1.0f / DM) + LN_EPS);
#pragma unroll
        for (int j = 0; j < 4; ++j) { const f32x4 g = ((const f32x4*)c.ln_g)[lane + 64 * j], bb = ((const f32x4*)c.ln_b)[lane + 64 * j]; rp[64 * j] = v[j] * rstd * g + bb; }
    }
}
__global__ void __launch_bounds__(256) k_ln(Ctx c) { ln_rows(c, blockIdx.x * 4 + (threadIdx.x >> 6), gridDim.x * 4, threadIdx.x & 63); }


namespace pg8 {
#define PG8_LAS __attribute__((address_space(3)))
typedef short bf16x8 __attribute__((ext_vector_type(8)));
typedef unsigned u32x4 __attribute__((ext_vector_type(4)));
constexpr int BM = 256, BK = 64, HALF = 128, HTB = HALF * BK * 2, STAGE_BYTES = 8 * HTB, NXCD = 8, WGM = 8;
__host__ __device__ __forceinline__ int lds_byte(int r, int c) { const int st = (r >> 4) * 2 + (c >> 5), rr = r & 15, cc = c & 31, ob = rr * 64 + cc * 2; return st * 1024 + (ob ^ (((ob >> 9) & 1) << 5)); }
__host__ __device__ __forceinline__ void stage_rc(int b, int& R, int& C) { const int st = b / 1024, sb = b % 1024, swz = sb ^ (((sb >> 9) & 1) << 5); R = (st >> 1) * 16 + swz / 64; C = (st & 1) * 32 + (swz % 64) / 2; }
__host__ __device__ __forceinline__ int perm32(int rho) { const int n = rho >> 4, i = rho & 15; return 8 * (i >> 2) + 4 * n + (i & 3); }
__device__ __forceinline__ unsigned cvt_pk_bf16(float lo, float hi) { unsigned r; asm volatile("v_cvt_pk_bf16_f32 %0, %1, %2" : "=v"(r) : "v"(lo), "v"(hi)); return r; }

struct GUnit { const char* A; const char* B; int nt, pm, pn, seg, last, cfg, aux; };
struct LoadCfg { unsigned voffA[2][2], voffB[2][2]; long hsA[2], hsB[2]; };
__device__ __forceinline__ void voff_plain(unsigned (&v)[2], int ld, bool perm) {
#pragma unroll
    for (int i = 0; i < 2; ++i) { int R, C; stage_rc(threadIdx.x * 16 + i * 8192, R, C); const int Rb = perm ? ((R & ~31) + perm32(R & 31)) : R; v[i] = (unsigned)(Rb * ld + C) * 2u; }
}
__device__ __forceinline__ bool tile_order(int nM, int nN, int G, int c, int i, int& pm, int& pn) {
    const int nwg = nM * nN; const long L = (long)i * G + c; if (L >= nwg) return false;
    int wgid = (int)L; { const int q = nwg / NXCD, r = nwg % NXCD, xcd = wgid % NXCD, off = wgid / NXCD; wgid = (xcd < r ? xcd * (q + 1) : r * (q + 1) + (xcd - r) * q) + off; }
    const int nig = WGM * nN, gid = wgid / nig, fm = gid * WGM, gsz = (nM - fm) < WGM ? (nM - fm) : WGM;
    pm = fm + ((wgid % nig) % gsz); pn = (wgid % nig) / gsz; return true;
}
template <class Epi, class Sched, bool ALIGN_EPI, bool SP2, int NCFG = 1>
__device__ __forceinline__ void gemm_phase(PG8_LAS unsigned char* lds, const LoadCfg& L, const Sched& S, const Epi& E) {
    const int tid = threadIdx.x, wid = __builtin_amdgcn_readfirstlane(tid >> 6), lane = tid & 63, wr = wid >> 2, wc = wid & 3, fr = lane & 15, fq = lane >> 4;
    const size_t kstep = (size_t)(BK * 2);
    const unsigned ldsw = (unsigned)wid * 1024u;
    const int aoff = lds_byte(wr * 64 + fr, fq * 8), boff = lds_byte(wc * 32 + fr, fq * 8);
#define PG8_SA(b, h) (((b) * 2 + (h)) * HTB)
#define PG8_SB(b, h) ((4 + (b) * 2 + (h)) * HTB)
#define PG8_STAGE(bufoff, gbase, voff) do { _Pragma("unroll") for (int _i = 0; _i < 2; ++_i) \
        __builtin_amdgcn_global_load_lds((const unsigned*)((const char*)(gbase) + (voff)[_i]), (PG8_LAS unsigned*)(lds + (bufoff) + ldsw + _i * 8192), 16, 0, 0); } while (0)
#define PG8_LDA(dst, b, h) do { _Pragma("unroll") for (int m = 0; m < 4; ++m) _Pragma("unroll") for (int k = 0; k < 2; ++k) dst[m][k] = *(const PG8_LAS bf16x8*)(lds + PG8_SA(b, h) + aoff + m * 2048 + k * 1024); } while (0)
#define PG8_LDB(dst, b, h) do { _Pragma("unroll") for (int n = 0; n < 2; ++n) _Pragma("unroll") for (int k = 0; k < 2; ++k) dst[n][k] = *(const PG8_LAS bf16x8*)(lds + PG8_SB(b, h) + boff + n * 2048 + k * 1024); } while (0)
#define PG8_MMA(ai, bj, At, Bt) do { __builtin_amdgcn_s_setprio(1); _Pragma("unroll") for (int m = 0; m < 4; ++m) _Pragma("unroll") for (int n = 0; n < 2; ++n) _Pragma("unroll") for (int k = 0; k < 2; ++k) \
        acc[ai][bj][m][n] = __builtin_amdgcn_mfma_f32_16x16x32_bf16(Bt[n][k], At[m][k], acc[ai][bj][m][n], 0, 0, 0); __builtin_amdgcn_s_setprio(0); } while (0)
#define PG8_WAIT_V(n) asm volatile("s_waitcnt vmcnt(" #n ")" ::: "memory")
#define PG8_WAIT_L(n) asm volatile("s_waitcnt lgkmcnt(" #n ")" ::: "memory")
#define PG8_BAR __builtin_amdgcn_s_barrier()
#define PG8_SCHED __builtin_amdgcn_sched_barrier(0)
    GUnit cur, nxt; int ui = 0;
    if (!S.next(0, cur)) return;
    f32x4 acc[2][2][4][2];
#pragma unroll
    for (int a = 0; a < 2; ++a)
#pragma unroll
        for (int b = 0; b < 2; ++b)
#pragma unroll
            for (int m = 0; m < 4; ++m)
#pragma unroll
                for (int n = 0; n < 2; ++n) acc[a][b][m][n] = (f32x4){0.f, 0.f, 0.f, 0.f};
    bf16x8 At[4][2], B0[2][2], B1[2][2];
    const char* cA = cur.A; const char* cB = cur.B;
    static_assert(SP2, "only the two-super-phase loop is kept here");
#define PG8_CFG(u) ((NCFG == 1) ? 0 : (u).cfg)
#define PG8_SELV(dst, src, cf) do { dst[0] = (NCFG == 1 || (cf) == 0) ? src[0][0] : src[1][0]; dst[1] = (NCFG == 1 || (cf) == 0) ? src[0][1] : src[1][1]; } while (0)
    unsigned vAc[2], vBc[2]; long hsA, hsB;
    { const int cf = PG8_CFG(cur); PG8_SELV(vAc, L.voffA, cf); PG8_SELV(vBc, L.voffB, cf); hsA = (NCFG == 1 || cf == 0) ? L.hsA[0] : L.hsA[1]; hsB = (NCFG == 1 || cf == 0) ? L.hsB[0] : L.hsB[1]; }
    PG8_STAGE(PG8_SB(0, 0), cB, vBc); PG8_STAGE(PG8_SB(0, 1), cB + hsB, vBc); PG8_STAGE(PG8_SA(0, 0), cA, vAc); PG8_STAGE(PG8_SA(0, 1), cA + hsA, vAc);
    if (wr == 1) PG8_BAR;
    PG8_WAIT_V(2); PG8_BAR;
    PG8_STAGE(PG8_SB(1, 0), cB + kstep, vBc); PG8_STAGE(PG8_SA(1, 0), cA + kstep, vAc); PG8_STAGE(PG8_SB(1, 1), cB + hsB + kstep, vBc);
    PG8_WAIT_V(6); PG8_BAR;
    for (;;) {
        const bool has_next = S.next(ui + 1, nxt);
        const char* nA = has_next ? nxt.A : cA; const char* nB = has_next ? nxt.B : cB;
        unsigned vAn[2], vBn[2]; long hsAn, hsBn;
        { const int cf = has_next ? PG8_CFG(nxt) : PG8_CFG(cur); PG8_SELV(vAn, L.voffA, cf); PG8_SELV(vBn, L.voffB, cf); hsAn = (NCFG == 1 || cf == 0) ? L.hsA[0] : L.hsA[1]; hsBn = (NCFG == 1 || cf == 0) ? L.hsB[0] : L.hsB[1]; }
        const int nt = cur.nt;
        for (int t = 0; t < nt; t += 2) {
            const bool last = (t == nt - 2);
            const char* a1 = cA + (size_t)(t + 1) * kstep;
            const char* a2 = last ? nA : cA + (size_t)(t + 2) * kstep; const char* b2 = last ? nB : cB + (size_t)(t + 2) * kstep;
            const char* a3 = a2 + kstep; const char* b3 = b2 + kstep;
            unsigned vA2[2], vB2[2]; long hA2, hB2;
            if (NCFG == 1) { vA2[0] = vAc[0]; vA2[1] = vAc[1]; vB2[0] = vBc[0]; vB2[1] = vBc[1]; hA2 = hsA; hB2 = hsB; }
            else { vA2[0] = last ? vAn[0] : vAc[0]; vA2[1] = last ? vAn[1] : vAc[1]; vB2[0] = last ? vBn[0] : vBc[0]; vB2[1] = last ? vBn[1] : vBc[1]; hA2 = last ? hsAn : hsA; hB2 = last ? hsBn : hsB; }
            PG8_LDB(B0, 0, 0); PG8_LDB(B1, 0, 1); PG8_SCHED; PG8_LDA(At, 0, 0); PG8_STAGE(PG8_SA(1, 1), a1 + hsA, vAc);
            PG8_WAIT_V(8); PG8_WAIT_L(0); PG8_BAR; PG8_MMA(0, 0, At, B0); PG8_MMA(0, 1, At, B1); PG8_BAR; PG8_SCHED;
            PG8_LDA(At, 0, 1); PG8_STAGE(PG8_SB(0, 0), b2, vB2); PG8_STAGE(PG8_SB(0, 1), b2 + hB2, vB2); PG8_STAGE(PG8_SA(0, 0), a2, vA2);
            PG8_WAIT_V(8); PG8_WAIT_L(0); PG8_BAR; PG8_MMA(1, 0, At, B0); PG8_MMA(1, 1, At, B1); PG8_BAR; PG8_SCHED;
            PG8_LDB(B0, 1, 0); PG8_LDB(B1, 1, 1); PG8_SCHED; PG8_LDA(At, 1, 0); PG8_STAGE(PG8_SA(0, 1), a2 + hA2, vA2);
            PG8_WAIT_V(8); PG8_WAIT_L(0); PG8_BAR; PG8_MMA(0, 0, At, B0); PG8_MMA(0, 1, At, B1); PG8_BAR; PG8_SCHED;
            PG8_LDA(At, 1, 1); PG8_STAGE(PG8_SB(1, 0), b3, vB2); PG8_STAGE(PG8_SB(1, 1), b3 + hB2, vB2); PG8_STAGE(PG8_SA(1, 0), a3, vA2);
            PG8_WAIT_V(8); PG8_WAIT_L(0); PG8_BAR; PG8_MMA(1, 0, At, B0); PG8_MMA(1, 1, At, B1); PG8_BAR; PG8_SCHED;
        }
        if constexpr (ALIGN_EPI) { if (wr == 0) PG8_BAR; }
        E(acc, cur, wr, wc, fr, fq);
        if (!has_next) break;
        if (cur.last) {
#pragma unroll
            for (int a = 0; a < 2; ++a)
#pragma unroll
                for (int b = 0; b < 2; ++b)
#pragma unroll
                    for (int m = 0; m < 4; ++m)
#pragma unroll
                        for (int n = 0; n < 2; ++n) acc[a][b][m][n] = (f32x4){0.f, 0.f, 0.f, 0.f};
        }
        cur = nxt; cA = nA; cB = nB; ++ui; vAc[0] = vAn[0]; vAc[1] = vAn[1]; vBc[0] = vBn[0]; vBc[1] = vBn[1]; hsA = hsAn; hsB = hsBn;
        if constexpr (ALIGN_EPI) { if (wr == 1) PG8_BAR; }
    }
    PG8_WAIT_V(0);
    if constexpr (!ALIGN_EPI) { if (wr == 0) PG8_BAR; }
    PG8_BAR;
#undef PG8_CFG
#undef PG8_SELV
#undef PG8_SA
#undef PG8_SB
#undef PG8_STAGE
#undef PG8_LDA
#undef PG8_LDB
#undef PG8_MMA
#undef PG8_WAIT_V
#undef PG8_WAIT_L
#undef PG8_BAR
#undef PG8_SCHED
}
}

typedef f32x4 acc_t[2][2][4][2];
__device__ __forceinline__ v4u pack8(const f32x4 a, const f32x4 b) { v4u w; w.x = pg8::cvt_pk_bf16(a[0], a[1]); w.y = pg8::cvt_pk_bf16(a[2], a[3]); w.z = pg8::cvt_pk_bf16(b[0], b[1]); w.w = pg8::cvt_pk_bf16(b[2], b[3]); return w; }
__device__ __forceinline__ void unpack8(const v4u w, f32x4& a, f32x4& b) {
    a[0] = __builtin_bit_cast(float, w.x << 16); a[1] = __builtin_bit_cast(float, w.x & 0xffff0000u); a[2] = __builtin_bit_cast(float, w.y << 16); a[3] = __builtin_bit_cast(float, w.y & 0xffff0000u);
    b[0] = __builtin_bit_cast(float, w.z << 16); b[1] = __builtin_bit_cast(float, w.z & 0xffff0000u); b[2] = __builtin_bit_cast(float, w.w << 16); b[3] = __builtin_bit_cast(float, w.w & 0xffff0000u); }
__device__ __forceinline__ float fast_sigmoid(float v) { return __builtin_amdgcn_rcpf(1.0f + __builtin_amdgcn_exp2f(-LOG2E * v)); }
template <class F> __device__ __forceinline__ f32x4 map4(const f32x4 v, F f) { return (f32x4){f(v[0]), f(v[1]), f(v[2]), f(v[3])}; }


namespace att {
typedef short bf16x8 __attribute__((ext_vector_type(8)));
typedef short s16x4 __attribute__((ext_vector_type(4)));
typedef float f32x16 __attribute__((ext_vector_type(16)));
#define ALAS __attribute__((address_space(3)))
constexpr int SLOT = 32768, L_BT = 98304, L_WSF = 99328;
constexpr float THR = 8.0f;
__device__ __forceinline__ int crow(int r, int hi) { return (r & 3) + 8 * (r >> 2) + 4 * hi; }
__device__ __forceinline__ float swapmax(float m) { auto rr = __builtin_amdgcn_permlane32_swap(__builtin_bit_cast(unsigned, m), __builtin_bit_cast(unsigned, m), false, false); return fmaxf(__builtin_bit_cast(float, rr[0]), __builtin_bit_cast(float, rr[1])); }
__device__ __forceinline__ float swapsum(float m) { auto rr = __builtin_amdgcn_permlane32_swap(__builtin_bit_cast(unsigned, m), __builtin_bit_cast(unsigned, m), false, false); return __builtin_bit_cast(float, rr[0]) + __builtin_bit_cast(float, rr[1]); }
__device__ __forceinline__ s16x4 vtr(const ALAS unsigned char* p) { typedef short v4i16_t __attribute__((ext_vector_type(4))); return __builtin_bit_cast(s16x4, __builtin_amdgcn_ds_read_tr16_b64_v4i16((ALAS v4i16_t*)p)); }
__device__ __forceinline__ void dma_tile(ALAS unsigned char* slot, const bf16* Kg, const bf16* Vg, size_t kvrow, int h, int w, int lane) {
#pragma unroll
    for (int i = 0; i < 2; ++i) { const int pc = w + 8 * i;
        __builtin_amdgcn_global_load_lds((const unsigned*)(Kg + (kvrow + lane) * 512 + h * 128 + pc * 8), (ALAS unsigned*)(slot + pc * 1024), 16, 0, 0); }
#pragma unroll
    for (int i = 0; i < 2; ++i) { const int pc = w + 8 * i, d0 = pc >> 2, kvg = pc & 3;
        __builtin_amdgcn_global_load_lds((const unsigned*)(Vg + (kvrow + 16 * kvg + (lane >> 2)) * 512 + h * 128 + d0 * 32 + (lane & 3) * 8), (ALAS unsigned*)(slot + 16384 + pc * 1024), 16, 0, 0); }
}
template <bool DIFF>
__device__ __forceinline__ void attn_unit(const Ctx& c, ALAS unsigned char* lds, int b, int h, int qb) {
    int tid_ = threadIdx.x; asm volatile("" : "+v"(tid_));
    const int tid = tid_, lane = tid & 63, r32 = lane & 31, hi = lane >> 5, w = __builtin_amdgcn_readfirstlane(tid >> 6);
    constexpr int NDS = DIFF ? 4 : 8, UR = DIFF ? 128 : 256;
    const int mapc = DIFF ? (w >> 2) : 0, wrow = DIFF ? 32 * (w & 3) : 32 * w, q0 = qb * UR;
    const size_t tok0 = (size_t)b * SEQ + q0, kvrow0 = DIFF ? (size_t)b * SEQ : (size_t)b * NMEM;
    bf16* Qg = DIFF ? WSP(bf16, WS_DQ) : WSP(bf16, WS_MQ); const bf16* Kg = DIFF ? WSP(bf16, WS_DK) : DOP(bf16, DO_MK); const bf16* Vg = DIFF ? WSP(bf16, WS_DV) : DOP(bf16, DO_MV);
    const bf16* Zg = DIFF ? WSP(bf16, WS_ZD) : WSP(bf16, WS_ZM); bf16* Og = DIFF ? WSP(bf16, WS_YD) : DOP(bf16, DO_YM);
    const int NT = DIFF ? (q0 + 128) / 64 : 4;
    const int nt_w = DIFF ? ((w & 3) < 2 ? NT - 1 : NT) : NT, near0 = DIFF ? nt_w - 3 : NT;
    ALAS float* bt = (ALAS float*)(lds + L_BT); ALAS float* wsf = (ALAS float*)(lds + L_WSF) + w * 64;
    bf16x8 qr[NDS];
#pragma unroll
    for (int ds = 0; ds < NDS; ++ds) qr[ds] = *(const bf16x8*)(Qg + (tok0 + wrow + r32) * 512 + h * 128 + mapc * 64 + ds * 16 + hi * 8);
    if (DIFF && tid < 256) bt[tid] = WSP(float, WS_SC)[256 + h * 256 + tid];
    const float bfar = DIFF ? WSP(float, WS_SC)[256 + h * 256] : 0.f;
    asm volatile("s_waitcnt vmcnt(0)" ::: "memory");
    dma_tile(lds, Kg, Vg, kvrow0, h, w, lane);
    if (NT > 1) dma_tile(lds + SLOT, Kg, Vg, kvrow0 + 64, h, w, lane);
    f32x16 o[4];
#pragma unroll
    for (int d0 = 0; d0 < 4; ++d0) o[d0] = f32x16{};
    float mref = 0.f, lsum = 0.f;
    const int vb = ((lane >> 4) & 1) * 32 + (lane & 3) * 8 + (4 * hi + ((lane & 15) >> 2)) * 64;
    for (int t = 0; t < NT; ++t) {
        if (t + 1 < NT) asm volatile("s_waitcnt vmcnt(4)" ::: "memory"); else asm volatile("s_waitcnt vmcnt(0)" ::: "memory");
        __builtin_amdgcn_s_barrier(); asm volatile("" ::: "memory");
        if (t + 2 < NT) dma_tile(lds + ((t + 2) % 3) * SLOT, Kg, Vg, kvrow0 + 64 * (t + 2), h, w, lane);
        if (t < nt_w) {
            const ALAS unsigned char* ks = lds + (t % 3) * SLOT; const ALAS unsigned char* vs = ks + 16384;
            const bool nearb = DIFF && t >= near0;
            const float cv = (nearb ? 0.f : bfar) - mref;
            f32x16 p0, p1;
#pragma unroll
            for (int r = 0; r < 16; ++r) { p0[r] = cv; p1[r] = cv; }
            const ALAS unsigned char* kp = ks + (mapc * 8 + hi) * 1024 + r32 * 16;
#pragma unroll
            for (int ds = 0; ds < NDS; ++ds) { const bf16x8 k0 = *(const ALAS bf16x8*)(kp + ds * 2048), k1 = *(const ALAS bf16x8*)(kp + ds * 2048 + 512);
                p0 = __builtin_amdgcn_mfma_f32_32x32x16_bf16(k0, qr[ds], p0, 0, 0, 0); p1 = __builtin_amdgcn_mfma_f32_32x32x16_bf16(k1, qr[ds], p1, 0, 0, 0); }
            if (nearb) { const int ib = 64 * t - q0 - wrow - r32 + 191 + 4 * hi;
#pragma unroll
                for (int r = 0; r < 16; ++r) { p0[r] += bt[ib + (r & 3) + 8 * (r >> 2)]; p1[r] += bt[ib + 32 + (r & 3) + 8 * (r >> 2)]; } }
            float rm = fmaxf(p0[0], p1[0]);
#pragma unroll
            for (int r = 1; r < 16; ++r) rm = fmaxf(rm, fmaxf(p0[r], p1[r]));
            rm = swapmax(rm);
            if (t == 0 || __any(rm > THR)) {
                const float dl = t == 0 ? rm : fmaxf(rm, 0.f); mref += dl;
#pragma unroll
                for (int r = 0; r < 16; ++r) { p0[r] -= dl; p1[r] -= dl; }
                if (t > 0) { const float f = __builtin_amdgcn_exp2f(-dl); lsum *= f; if (hi == 0) wsf[r32] = f;
#pragma unroll
                    for (int r = 0; r < 16; ++r) { const float fr = wsf[crow(r, hi)];
#pragma unroll
                        for (int d0 = 0; d0 < 4; ++d0) o[d0][r] *= fr; } }
            }
            float ps = 0.f;
#pragma unroll
            for (int r = 0; r < 16; ++r) { p0[r] = __builtin_amdgcn_exp2f(p0[r]); p1[r] = __builtin_amdgcn_exp2f(p1[r]); ps += p0[r] + p1[r]; }
            lsum += ps;
            bf16x8 pa[4];
#pragma unroll
            for (int kk = 0; kk < 4; ++kk) { const f32x16& P = (kk < 2) ? p0 : p1; const int r0 = 8 * (kk & 1);
                const v4u pw = {pg8::cvt_pk_bf16(P[r0], P[r0 + 1]), pg8::cvt_pk_bf16(P[r0 + 2], P[r0 + 3]), pg8::cvt_pk_bf16(P[r0 + 4], P[r0 + 5]), pg8::cvt_pk_bf16(P[r0 + 6], P[r0 + 7])};
                pa[kk] = __builtin_bit_cast(bf16x8, pw); }
#pragma unroll
            for (int d0 = 0; d0 < 4; ++d0)
#pragma unroll
                for (int kk = 0; kk < 4; ++kk) { const s16x4 lo = vtr(vs + d0 * 4096 + kk * 1024 + vb), hh = vtr(vs + d0 * 4096 + kk * 1024 + 512 + vb);
                    const bf16x8 vf = {lo[0], lo[1], lo[2], lo[3], hh[0], hh[1], hh[2], hh[3]};
                    o[d0] = __builtin_amdgcn_mfma_f32_32x32x16_bf16(pa[kk], vf, o[d0], 0, 0, 0); }
        }
    }
    lsum = swapsum(lsum);
    asm volatile("s_waitcnt lgkmcnt(0)" ::: "memory"); __builtin_amdgcn_s_barrier(); asm volatile("" ::: "memory");
    if (hi == 0) wsf[32 + r32] = lsum;
    float rl[16];
#pragma unroll
    for (int r = 0; r < 16; ++r) rl[r] = 1.0f / wsf[32 + crow(r, hi)];
    if (DIFF) {
        ALAS float* st1 = (ALAS float*)(lds + (w & 3) * 16384);
        if (mapc == 1) {
#pragma unroll
            for (int d0 = 0; d0 < 4; ++d0)
#pragma unroll
                for (int r = 0; r < 16; ++r) st1[(d0 * 16 + r) * 64 + lane] = o[d0][r] * rl[r];
        }
        asm volatile("s_waitcnt lgkmcnt(0)" ::: "memory"); __builtin_amdgcn_s_barrier(); asm volatile("" ::: "memory");
        if (mapc == 0) {
            const float lam = WSP(float, WS_SC)[0]; float ss[16];
#pragma unroll
            for (int r = 0; r < 16; ++r) { float a = 0.f;
#pragma unroll
                for (int d0 = 0; d0 < 4; ++d0) { const float v = o[d0][r] * rl[r] - lam * st1[(d0 * 16 + r) * 64 + lane]; o[d0][r] = v; a += v * v; }
                ss[r] = a; }
#pragma unroll
            for (int r = 0; r < 16; ++r) { float a = ss[r]; a += __shfl_xor(a, 1); a += __shfl_xor(a, 2); a += __shfl_xor(a, 4); a += __shfl_xor(a, 8); a += __shfl_xor(a, 16);
                ss[r] = rsqrtf(a * (1.0f / 128.0f) + RMS_EPS) * (1.0f - LAMBDA_INIT); }
            ALAS bf16* st0 = (ALAS bf16*)(lds + 65536 + w * 8192);
#pragma unroll
            for (int d0 = 0; d0 < 4; ++d0) { const float sw = c.subln[d0 * 32 + r32];
#pragma unroll
                for (int r = 0; r < 16; ++r) st0[crow(r, hi) * 128 + d0 * 32 + r32] = (bf16)f2bf(o[d0][r] * ss[r] * sw); }
            asm volatile("s_waitcnt lgkmcnt(0)" ::: "memory");
#pragma unroll
            for (int i = 0; i < 8; ++i) { const int row = 4 * i + (lane >> 4), ch = lane & 15; const size_t gi = (tok0 + wrow + row) * 512 + h * 128 + ch * 8;
                f32x4 y0, y1, z0, z1; unpack8(*(const ALAS v4u*)(st0 + row * 128 + ch * 8), y0, y1); unpack8(*(const v4u*)(Zg + gi), z0, z1);
                *(v4u*)(Og + gi) = pack8(y0 * z0, y1 * z1); }
        }
    } else {
        ALAS bf16* st0 = (ALAS bf16*)(lds + w * 8192);
#pragma unroll
        for (int d0 = 0; d0 < 4; ++d0)
#pragma unroll
            for (int r = 0; r < 16; ++r) st0[crow(r, hi) * 128 + d0 * 32 + r32] = (bf16)f2bf(o[d0][r] * rl[r]);
        asm volatile("s_waitcnt lgkmcnt(0)" ::: "memory");
#pragma unroll
        for (int i = 0; i < 8; ++i) { const int row = 4 * i + (lane >> 4), ch = lane & 15; const size_t gi = (tok0 + wrow + row) * 512 + h * 128 + ch * 8;
            f32x4 y0, y1, z0, z1; unpack8(*(const ALAS v4u*)(st0 + row * 128 + ch * 8), y0, y1); unpack8(*(const v4u*)(Zg + gi), z0, z1);
            *(v4u*)(Og + gi) = pack8(y0 * z0, y1 * z1); }
    }
    asm volatile("s_waitcnt vmcnt(0) lgkmcnt(0)" ::: "memory"); __builtin_amdgcn_s_barrier(); asm volatile("" ::: "memory");
}
__device__ __forceinline__ void attn_phase(const Ctx& c, ALAS unsigned char* lds, int G, int cu) {
    const int vcu = (G % 8 == 0) ? (cu % 8) * (G / 8) + cu / 8 : cu;
    for (int u = vcu; u < 256; u += G) { const int bh = u >> 3, sx = u & 7;
        for (int i = 0; i < 4; ++i) { const int qb = (i == 0) ? sx : (i == 1) ? 15 - sx : (i == 2) ? 16 + sx : 31 - sx; attn_unit<true>(c, lds, bh >> 2, bh & 3, qb); } }
    for (int u = vcu; u < 512; u += G) attn_unit<false>(c, lds, u >> 6, (u >> 4) & 3, u & 15);
}
}

struct EpiP1 {
    unsigned char* ws;
    __device__ __forceinline__ void operator()(acc_t& acc, const pg8::GUnit& u, int wr, int wc, int fr, int fq) const {
        const int seg = u.pn >> 1;
        const int row0 = u.pm * 256 + wr * 64 + fr;
#pragma unroll
        for (int ai = 0; ai < 2; ++ai)
#pragma unroll
            for (int m = 0; m < 4; ++m) { const int row = row0 + ai * 128 + m * 16;
#pragma unroll
                for (int bj = 0; bj < 2; ++bj) { const int col8 = u.pn * 256 + bj * 128 + wc * 32 + 8 * fq; f32x4 v0 = acc[ai][bj][m][0], v1 = acc[ai][bj][m][1]; bf16* dst;
                    if (seg >= 8) { v0 = map4(v0, fast_sigmoid); v1 = map4(v1, fast_sigmoid); dst = (bf16*)(ws + WS_GT) + (size_t)row * 3072 + (col8 - 4096); }
                    else if (seg == 0) { const int cc = col8 & 511; dst = (bf16*)(ws + WS_UG) + ((((size_t)(cc >> 4) * NCOL + (row >> 6)) * 64 + (row & 63)) * 16 + (cc & 15)); }
                    else { if (seg == 1 || seg == 5 || seg == 7) { v0 = v0 * map4(v0, fast_sigmoid); v1 = v1 * map4(v1, fast_sigmoid); } else if (seg == 2) { v0 = v0 * QS_DIFF; v1 = v1 * QS_DIFF; } else if (seg == 6) { v0 = v0 * QS_MEM; v1 = v1 * QS_MEM; }
                        dst = (bf16*)(ws + WS_PROJ + (size_t)seg * SEGB) + (size_t)row * 512 + (col8 & 511); }
                    *(v4u*)dst = pack8(v0, v1); } }
    }
};
struct EpiMKV {
    bf16 *mk, *mv;
    __device__ __forceinline__ void operator()(acc_t& acc, const pg8::GUnit& u, int wr, int wc, int fr, int fq) const {
        const int row0 = u.pm * 256 + wr * 64 + fr; bf16* base = u.pn < 2 ? mk : mv;
#pragma unroll
        for (int ai = 0; ai < 2; ++ai)
#pragma unroll
            for (int m = 0; m < 4; ++m) { const int row = row0 + ai * 128 + m * 16;
#pragma unroll
                for (int bj = 0; bj < 2; ++bj) { const int col8 = (u.pn & 1) * 256 + bj * 128 + wc * 32 + 8 * fq; *(v4u*)(base + (size_t)row * 512 + col8) = pack8(acc[ai][bj][m][0], acc[ai][bj][m][1]); } }
    }
};
struct EpiGLU {
    const bf16* zs; bf16* ys;
    __device__ __forceinline__ void operator()(acc_t& acc, const pg8::GUnit& u, int wr, int wc, int fr, int fq) const {
        const int row0 = u.pm * 256 + wr * 64 + fr, ch8 = u.pn * 128 + wc * 32 + 8 * fq;
#pragma unroll
        for (int ai = 0; ai < 2; ++ai)
#pragma unroll
            for (int m = 0; m < 4; ++m) { const size_t off = (size_t)(row0 + ai * 128 + m * 16) * 512 + ch8; f32x4 z0, z1; unpack8(*(const v4u*)(zs + off), z0, z1);
                const f32x4 y0 = acc[ai][0][m][0] * map4(acc[ai][1][m][0], fast_sigmoid) * z0, y1 = acc[ai][0][m][1] * map4(acc[ai][1][m][1], fast_sigmoid) * z1;
                *(v4u*)(ys + off) = pack8(y0, y1); }
    }
};
struct EpiMerge {
    const bf16* gt; bf16* mg;
    __device__ __forceinline__ void operator()(acc_t& acc, const pg8::GUnit& u, int wr, int wc, int fr, int fq) const {
        const int row0 = u.pm * 256 + wr * 64 + fr, s = u.seg;
#pragma unroll
        for (int ai = 0; ai < 2; ++ai)
#pragma unroll
            for (int m = 0; m < 4; ++m) { const int row = row0 + ai * 128 + m * 16;
#pragma unroll
                for (int bj = 0; bj < 2; ++bj) { const int col8 = u.pn * 256 + bj * 128 + wc * 32 + 8 * fq; const bf16* gp = gt + (size_t)row * 3072 + s * 1024 + col8;
                    f32x4 a0, a1; unpack8(*(const v4u*)gp, a0, a1);
                    if (s < 2) { f32x4 b0, b1; unpack8(*(const v4u*)(gp + 1024), b0, b1);
                        auto rc = [](float x) { return __builtin_amdgcn_rcpf(fmaxf(x, 1e-30f)); };
                        acc[ai][bj][m][0] = acc[ai][bj][m][0] * (a0 * map4(b0, rc)); acc[ai][bj][m][1] = acc[ai][bj][m][1] * (a1 * map4(b1, rc)); }
                    else *(v4u*)(mg + (size_t)row * 1024 + col8) = pack8(acc[ai][bj][m][0] * a0, acc[ai][bj][m][1] * a1); } }
    }
};
struct EpiOut {
    const float* x; float* out;
    __device__ __forceinline__ void operator()(acc_t& acc, const pg8::GUnit& u, int wr, int wc, int fr, int fq) const {
        const int row0 = u.pm * 256 + wr * 64 + fr, col0 = u.pn * 256 + wc * 32 + 4 * fq;
#pragma unroll
        for (int ai = 0; ai < 2; ++ai)
#pragma unroll
            for (int m = 0; m < 4; ++m) { const size_t off = (size_t)(row0 + ai * 128 + m * 16) * 1024 + col0;
#pragma unroll
                for (int bj = 0; bj < 2; ++bj)
#pragma unroll
                    for (int n = 0; n < 2; ++n) { const f32x4 xv = *(const f32x4*)(x + off + bj * 128 + n * 16); *(f32x4*)(out + off + bj * 128 + n * 16) = xv * ALPHA + acc[ai][bj][m][n]; } }
    }
};

struct EpiF {
    float* F;
    __device__ __forceinline__ void operator()(acc_t& acc, const pg8::GUnit& u, int wr, int wc, int fr, int fq) const {
        const int row0 = u.pm * 256 + wr * 64 + fr, col0 = wc * 32 + 4 * fq; float* base = F + (size_t)u.aux * NCOL * 128;
#pragma unroll
        for (int ai = 0; ai < 2; ++ai)
#pragma unroll
            for (int m = 0; m < 4; ++m)
#pragma unroll
                for (int n = 0; n < 2; ++n) *(f32x4*)(base + (size_t)(row0 + ai * 128 + m * 16) * 128 + col0 + n * 16) = acc[ai][0][m][n];
    }
};
struct SchedF {
    const char* UG; const char* WG; int G, c;
    __device__ __forceinline__ bool next(int i, pg8::GUnit& u) const { const int idx = i * G + c; if (idx >= 64) return false; const int g = idx >> 1, pm = idx & 1;
        u.A = UG + ((size_t)g * NCOL + pm * 256) * 1024 * 2; u.B = WG + (size_t)g * 128 * 1024 * 2; u.nt = 16; u.pm = pm; u.pn = 0; u.seg = 0; u.last = 1; u.cfg = 0; u.aux = g; return true; }
};
struct EpiS5Y {
    const bf16* UG; const float* dskip; bf16* VB;
    __device__ __forceinline__ void operator()(acc_t& acc, const pg8::GUnit& u, int wr, int wc, int fr, int fq) const {
        if (!u.last) return;
        const int g = u.aux, row0 = u.pm * 256 + wr * 64 + fr;
#pragma unroll
        for (int bj = 0; bj < 2; ++bj) { const int n8 = u.pn * 256 + bj * 128 + wc * 32 + 8 * fq, i = n8 >> 4, h0 = n8 & 15;
            const f32x4 d0 = *(const f32x4*)(dskip + g * 16 + h0), d1 = *(const f32x4*)(dskip + g * 16 + h0 + 4);
#pragma unroll
            for (int ai = 0; ai < 2; ++ai)
#pragma unroll
                for (int m = 0; m < 4; ++m) { const int r = row0 + ai * 128 + m * 16; f32x4 u0, u1; unpack8(*(const v4u*)(UG + ((size_t)g * NCOL + r) * 1024 + n8), u0, u1);
                    auto ge = [](float v) { const float t = 0.7978845608028654f * (v + 0.044715f * v * v * v); return v * __builtin_amdgcn_rcpf(1.0f + __builtin_amdgcn_exp2f(-2.0f * LOG2E * t)); };
                    const f32x4 y0 = map4(acc[ai][bj][m][0] + d0 * u0, ge), y1 = map4(acc[ai][bj][m][1] + d1 * u1, ge);
                    *(v4u*)(VB + ((size_t)r * 64 + i) * 512 + g * 16 + h0) = pack8(y0, y1); } }
    }
};
struct SchedS5Y {
    const char* UG; const char* TGC; const char* HH; const char* GG; int G, c;
    __device__ __forceinline__ bool next(int i, pg8::GUnit& u) const { const int idx = (i >> 1) * G + c, s = i & 1; if (idx >= 256) return false; const int g = idx >> 3, pm = (idx >> 2) & 1, pn = 3 - (idx & 3);
        u.pm = pm; u.pn = pn; u.seg = s; u.last = s; u.cfg = s; u.aux = g;
        if (s == 0) { u.A = UG + ((size_t)g * NCOL + pm * 256) * 1024 * 2; u.B = TGC + (size_t)g * 16 * 127 * 16 * 2 - 512 * pn; u.nt = 4 * (pn + 1); }
        else { u.A = HH + ((size_t)g * NCOL + pm * 256) * 256 * 2; u.B = GG + ((size_t)g * 1024 + pn * 256) * 128 * 2; u.nt = 4; }
        return true; }
};
__device__ __forceinline__ void s5_scan(const Ctx& c, int gt, int ngt) {
    const float* F = DOP(float, DO_F); bf16* HH = DOP(bf16, DO_HH); const float* LP = WSP(float, WS_LP);
    for (int idx = gt; idx < NG * NB * NP; idx += ngt) {
        const int p = idx & 63, b = (idx >> 6) & 7, g = idx >> 9; const float ar = LP[(g * NP + p) * 2], ai = LP[(g * NP + p) * 2 + 1];
        float hr = 0.f, hi = 0.f; const float* f = F + ((size_t)g * NCOL + b * 64) * 128 + p; bf16* hh = HH + ((size_t)g * NCOL + b * 64) * 256 + p;
#pragma unroll 16
        for (int n = 0; n < 64; ++n) { hh[n * 256] = (bf16)f2bf(hr); hh[n * 256 + 64] = (bf16)f2bf(hi); hh[n * 256 + 128] = 0; hh[n * 256 + 192] = 0;
            const float fr = f[n * 128], fi = f[n * 128 + 64]; const float nr = ar * hr - ai * hi + fr, ni = ar * hi + ai * hr + fi; hr = nr; hi = ni; }
    }
}
struct SchedPlain {
    const char* A; const char* B; int nM, nN, G, c, nt; size_t tA, tB;
    __device__ __forceinline__ bool next(int i, pg8::GUnit& u) const { int pm, pn; if (!pg8::tile_order(nM, nN, G, c, i, pm, pn)) return false;
        u.A = A + (size_t)pm * tA; u.B = B + (size_t)pn * tB; u.nt = nt; u.pm = pm; u.pn = pn; u.seg = 0; u.last = 1; u.cfg = 0; u.aux = 0; return true; }
};
struct SchedMerge {
    const char* A0; const char* A1; const char* A2; const char* B; int G, c;
    __device__ __forceinline__ bool next(int i, pg8::GUnit& u) const { int pm, pn; const int s = i % 3; if (!pg8::tile_order(128, 4, G, c, i / 3, pm, pn)) return false;
        u.A = (s == 0 ? A0 : (s == 1 ? A1 : A2)) + (size_t)pm * 256 * 512 * 2; u.B = B + ((size_t)pn * 256 * 1536 + 512 * s) * 2; u.nt = 8; u.pm = pm; u.pn = pn; u.seg = s; u.last = (s == 2); u.cfg = 0; u.aux = 0; return true; }
};

constexpr int MK_LDS = 147456;
enum { PH_P0 = 0, PH_PROJ = 1, PH_MIX = 2, PH_SCAN = 3, PH_S5Y = 4, PH_GLU = 5, PH_MERGE = 6, PH_OUT = 7, PH_LN = 8, PH_N = 9 };
__global__ void __launch_bounds__(512, 2) mk_fwd(Ctx c) {
    extern __shared__ __attribute__((aligned(16))) unsigned char lds[];
    PG8_LAS unsigned char* L3 = (PG8_LAS unsigned char*)lds;
    const int G = gridDim.x, cu = blockIdx.x;
    const int lane = threadIdx.x & 63, wave = __builtin_amdgcn_readfirstlane(threadIdx.x >> 6);
#define IN(k) (c.ph_lo <= (k) && (k) < c.ph_hi)
#define REPEAT(k) for (int rep_ = 0; rep_ <= ((REP_MASK >> (k)) & 1); ++rep_) if (rep_ == 0 || (cooperative_groups::this_grid().sync(), true))
#define SEAM(k) do { if (c.coop && IN(k) && IN((k) + 1)) cooperative_groups::this_grid().sync(); } while (0)
    if (IN(PH_P0)) REPEAT(PH_P0) p0_prologue(c, cu * 8 + wave, G * 8, lane, (float*)(lds + wave * 16384));
    SEAM(PH_P0);
    if (IN(PH_PROJ)) REPEAT(PH_PROJ) {
        { pg8::LoadCfg L; pg8::voff_plain(L.voffA[0], 1024, false); pg8::voff_plain(L.voffB[0], 1024, true); L.hsA[0] = 128 * 1024 * 2; L.hsB[0] = 128 * 1024 * 2;
          SchedPlain S{(const char*)DOP(bf16, DO_XB), (const char*)WSP(bf16, WS_WINT), 128, 28, G, cu, 16, (size_t)256 * 1024 * 2, (size_t)256 * 1024 * 2};
          EpiP1 E{c.ws}; pg8::gemm_phase<EpiP1, SchedPlain, true, true>(L3, L, S, E); }
        { pg8::LoadCfg L; pg8::voff_plain(L.voffA[0], 1024, false); pg8::voff_plain(L.voffB[0], 1024, true); L.hsA[0] = 128 * 1024 * 2; L.hsB[0] = 128 * 1024 * 2;
          SchedPlain S{(const char*)DOP(bf16, DO_MEMB), (const char*)WSP(bf16, WS_WMKVT), 8, 4, G, cu, 16, (size_t)256 * 1024 * 2, (size_t)256 * 1024 * 2};
          EpiMKV E{DOP(bf16, DO_MK), DOP(bf16, DO_MV)}; pg8::gemm_phase<EpiMKV, SchedPlain, true, true>(L3, L, S, E); }
    }
    SEAM(PH_PROJ);
    if (IN(PH_MIX)) REPEAT(PH_MIX) {
#if !USE_NAIVE_ATTN
        att::attn_phase(c, L3, G, cu);
#endif
        pg8::LoadCfg L; pg8::voff_plain(L.voffA[0], 1024, false); pg8::voff_plain(L.voffB[0], 1024, false); L.hsA[0] = 128 * 1024 * 2; L.hsB[0] = 0;
        SchedF S{(const char*)WSP(bf16, WS_UG), (const char*)DOP(bf16, DO_WG), G, cu};
        EpiF E{DOP(float, DO_F)}; pg8::gemm_phase<EpiF, SchedF, true, true>(L3, L, S, E);
    }
    SEAM(PH_MIX);
    if (IN(PH_SCAN)) REPEAT(PH_SCAN) s5_scan(c, cu * 512 + threadIdx.x, G * 512);
    SEAM(PH_SCAN);
    if (IN(PH_S5Y)) REPEAT(PH_S5Y) {
        pg8::LoadCfg L; pg8::voff_plain(L.voffA[0], 1024, false); pg8::voff_plain(L.voffA[1], 256, false); pg8::voff_plain(L.voffB[1], 128, true);
        L.hsA[0] = 128 * 1024 * 2; L.hsA[1] = 128 * 256 * 2; L.hsB[0] = -256; L.hsB[1] = 128 * 128 * 2;
#pragma unroll
        for (int i = 0; i < 2; ++i) { int R, C; pg8::stage_rc(threadIdx.x * 16 + i * 8192, R, C); const int Rb = (R & ~31) + pg8::perm32(R & 31);
            L.voffB[0][i] = (unsigned)((Rb & 15) * 127 * 16 + (63 - (Rb >> 4)) * 16 + C) * 2u; }
        SchedS5Y S{(const char*)WSP(bf16, WS_UG), (const char*)DOP(bf16, DO_TGC), (const char*)DOP(bf16, DO_HH), (const char*)DOP(bf16, DO_GG), G, cu};
        EpiS5Y E{WSP(bf16, WS_UG), c.d_skip, DOP(bf16, DO_VB)}; pg8::gemm_phase<EpiS5Y, SchedS5Y, true, true, 2>(L3, L, S, E);
    }
    SEAM(PH_S5Y);
    if (IN(PH_GLU)) REPEAT(PH_GLU) {
        pg8::LoadCfg L; pg8::voff_plain(L.voffA[0], 512, false); pg8::voff_plain(L.voffB[0], 512, true); L.hsA[0] = 128 * 512 * 2; L.hsB[0] = 128 * 512 * 2;
        SchedPlain S{(const char*)DOP(bf16, DO_VB), (const char*)WSP(bf16, WS_WGLUT), 128, 4, G, cu, 8, (size_t)256 * 512 * 2, (size_t)256 * 512 * 2};
        EpiGLU E{WSP(bf16, WS_ZS), WSP(bf16, WS_YS)}; pg8::gemm_phase<EpiGLU, SchedPlain, true, true>(L3, L, S, E);
    }
    SEAM(PH_GLU);
    if (IN(PH_MERGE)) REPEAT(PH_MERGE) {
        pg8::LoadCfg L; pg8::voff_plain(L.voffA[0], 512, false); pg8::voff_plain(L.voffB[0], 1536, true); L.hsA[0] = 128 * 512 * 2; L.hsB[0] = 128 * 1536 * 2;
        SchedMerge S{(const char*)WSP(bf16, WS_YS), (const char*)WSP(bf16, WS_YD), (const char*)DOP(bf16, DO_YM), (const char*)WSP(bf16, WS_WBRT), G, cu};
        EpiMerge E{WSP(bf16, WS_GT), WSP(bf16, WS_MG)}; pg8::gemm_phase<EpiMerge, SchedMerge, true, true>(L3, L, S, E);
    }
    SEAM(PH_MERGE);
    if (IN(PH_OUT)) REPEAT(PH_OUT) {
        pg8::LoadCfg L; pg8::voff_plain(L.voffA[0], 1024, false); pg8::voff_plain(L.voffB[0], 1024, false); L.hsA[0] = 128 * 1024 * 2; L.hsB[0] = 128 * 1024 * 2;
        SchedPlain S{(const char*)WSP(bf16, WS_MG), (const char*)WSP(bf16, WS_WOUTT), 128, 4, G, cu, 16, (size_t)256 * 1024 * 2, (size_t)256 * 1024 * 2};
        EpiOut E{c.x, c.out}; pg8::gemm_phase<EpiOut, SchedPlain, true, true>(L3, L, S, E);
    }
    SEAM(PH_OUT);
    if (IN(PH_LN)) ln_rows(c, cu * 8 + wave, G * 8, lane);
#undef IN
#undef SEAM
#undef REPEAT
}

extern "C" void kernel_launch(void* const* d_in, const int* in_sizes, int n_in, void* d_out, int out_size, void* d_ws, size_t ws_size, hipStream_t stream) {
    static int ok = 0, grid = 0;
    if (ok == 0) {
        if (n_in != 25 || in_sizes[0] != T * DM || out_size != T * DM || ws_size < WS_END) { fprintf(stderr, "kernel_launch: unexpected shapes (n_in %d, in0 %d, out %d, ws %zu)\n", n_in, in_sizes[0], out_size, ws_size); ok = -1; return; }
        (void)hipFuncSetAttribute((const void*)mk_fwd, hipFuncAttributeMaxDynamicSharedMemorySize, MK_LDS);
        (void)hipFuncSetAttribute((const void*)nk_attn<true>, hipFuncAttributeMaxDynamicSharedMemorySize, 98304);
        (void)hipFuncSetAttribute((const void*)nk_attn<false>, hipFuncAttributeMaxDynamicSharedMemorySize, 98304);
        int dev = 0, cus = 0, per_cu = 0;
        (void)hipGetDevice(&dev); (void)hipDeviceGetAttribute(&cus, hipDeviceAttributeMultiprocessorCount, dev);
        (void)hipOccupancyMaxActiveBlocksPerMultiprocessor(&per_cu, (const void*)mk_fwd, 512, MK_LDS);
        grid = cus * (per_cu < 1 ? 1 : 1);
        if (per_cu < 1) fprintf(stderr, "kernel_launch: occupancy query reports %d blocks per CU\n", per_cu);
        ok = 1;
    }
    if (ok < 0) return;
    Ctx c{};
    const float** f = (const float**)&c.x;
    for (int i = 0; i < 25; ++i) f[i] = (const float*)d_in[i];
    c.out = (float*)d_out; c.ws = (unsigned char*)d_ws; c.ph_lo = 0; c.ph_hi = 0;
#if ONE_LAUNCH
    c.ph_lo = 0; c.ph_hi = PH_N; c.coop = 1;
    void* args[] = {&c};
    hipError_t e = hipLaunchCooperativeKernel((const void*)mk_fwd, dim3(grid), dim3(512), args, MK_LDS, stream);
    if (e != hipSuccess) fprintf(stderr, "cooperative launch failed: %s (grid %d)\n", hipGetErrorString(e), grid);
#else
    auto run = [&](int lo, int hi) { c.ph_lo = lo; c.ph_hi = hi; c.coop = 0; hipLaunchKernelGGL(mk_fwd, dim3(256), dim3(512), MK_LDS, stream, c); };
    run(PH_P0, PH_P0 + 1);
    run(PH_PROJ, PH_PROJ + 1);
#if USE_NAIVE_ATTN
    hipLaunchKernelGGL(nk_attn<true>, dim3(NB * 4 * 64), dim3(256), 83968, stream, c);
    hipLaunchKernelGGL(nk_attn<false>, dim3(NB * 4 * 64), dim3(256), 83968, stream, c);
#endif
#if USE_NAIVE_S5
    hipLaunchKernelGGL(nk_s5, dim3(NB * NG), dim3(64), 0, stream, c);
#else
    run(PH_MIX, PH_MIX + 1); run(PH_SCAN, PH_SCAN + 1); run(PH_S5Y, PH_S5Y + 1);
#endif
    run(PH_GLU, PH_GLU + 1);
    run(PH_MERGE, PH_MERGE + 1);
    run(PH_OUT, PH_OUT + 1);
    run(PH_LN, PH_LN + 1);
#endif
}
```

```cpp
#include <hip/hip_runtime.h>
#include <hip/hip_cooperative_groups.h>
#include <cstdio>
#include <cstdint>
#include <cmath>

#ifndef DUP_PROJ
#define DUP_PROJ 1
#define DUP_S5Y 1
#define DUP_GLU 1
#define DUP_MERGE 1
#define DUP_OUT 1
#endif
#ifndef EXTRA_SYNCS
#define EXTRA_SYNCS 0
#endif
#ifndef LN_DRY
#define LN_DRY 0
#endif
#ifndef REP_MASK
#define REP_MASK 0
#endif
#ifndef ONE_LAUNCH
#define ONE_LAUNCH 1
#endif
#ifndef USE_NAIVE_ATTN
#define USE_NAIVE_ATTN 0
#endif
#ifndef USE_NAIVE_S5
#define USE_NAIVE_S5 0
#endif
typedef unsigned short bf16;
typedef unsigned v4u __attribute__((ext_vector_type(4)));
typedef float f32x4 __attribute__((ext_vector_type(4)));

constexpr int NB = 8, SEQ = 4096, DM = 1024, T = NB * SEQ, DIN = 7168, NMEM = 256;
constexpr int NG = 32, NP = 64, NH16 = 16, CL = 64, NCOL = T / CL;
constexpr float LN_EPS = 1e-5f, RMS_EPS = 1e-5f, LOG2E = 1.4426950408889634f;
constexpr float ALPHA = 1.189207115002721f;
constexpr float LAMBDA_INIT = 0.2f;
constexpr float QS_DIFF = 0.125f * LOG2E, QS_MEM = 0.08838834764831845f * LOG2E;

constexpr size_t MiB = 1u << 20;
constexpr size_t WS_CTL = 0;
constexpr size_t WS_SC = 64 * 1024;
constexpr size_t WS_LP = 128 * 1024;
constexpr size_t WS_WINT = 1 * MiB, WS_WGLUT = 15 * MiB, WS_WMKVT = 16 * MiB, WS_WBRT = 18 * MiB, WS_WOUTT = 21 * MiB;
constexpr size_t WS_PROJ = 64 * MiB, SEGB = 32 * MiB;
constexpr size_t WS_UG = WS_PROJ, WS_ZS = WS_PROJ + SEGB, WS_DQ = WS_PROJ + 2 * SEGB, WS_DK = WS_PROJ + 3 * SEGB, WS_DV = WS_PROJ + 4 * SEGB,
                 WS_ZD = WS_PROJ + 5 * SEGB, WS_MQ = WS_PROJ + 6 * SEGB, WS_ZM = WS_PROJ + 7 * SEGB, WS_GT = WS_PROJ + 8 * SEGB;
constexpr size_t WS_YD = 24 * MiB;
constexpr size_t WS_YS = WS_UG;
constexpr size_t WS_MG = WS_DK;
constexpr size_t WS_END = 512 * MiB;
constexpr size_t DO_XB = 0, DO_VB = 0  , DO_YM = 32 * MiB  , DO_MEMB = 64 * MiB, DO_TGC = 68 * MiB, DO_WG = 70 * MiB, DO_GG = 78 * MiB,
                 DO_F = 87 * MiB, DO_HH = 95 * MiB, DO_MK = 103 * MiB, DO_MV = 105 * MiB;

struct Ctx {
    const float *x, *mem, *w_in, *lam_re, *lam_im, *log_dt, *b_re, *b_im, *c_re, *c_im, *d_skip, *w_glu, *lq1, *lk1, *lq2, *lk2, *subln, *rel_bias, *w_mem_kv,
        *w_br_ssm, *w_br_diff, *w_br_mem, *w_out, *ln_g, *ln_b;
    float* out; unsigned char* ws;
    int ph_lo, ph_hi, coop, pad;
};
#define WSP(T_, off) ((T_*)(c.ws + (off)))
#define DOP(T_, off) ((T_*)((unsigned char*)c.out + (off)))

__device__ __forceinline__ unsigned f2bf(float f) { unsigned u = __builtin_bit_cast(unsigned, f); return (u + 0x7fffu + ((u >> 16) & 1u)) >> 16; }
__device__ __forceinline__ float bf2f(bf16 h) { return __builtin_bit_cast(float, (unsigned)h << 16); }
__device__ __forceinline__ unsigned pk2(float lo, float hi) { return f2bf(lo) | (f2bf(hi) << 16); }
__device__ __forceinline__ float sigmoidf_(float v) { return 1.0f / (1.0f + __expf(-v)); }
__device__ __forceinline__ float siluf_(float v) { return v * sigmoidf_(v); }
__device__ __forceinline__ float gelu_tanh(float v) { const float u = 0.7978845608028654f * (v + 0.044715f * v * v * v); const float e = __expf(2.0f * u); const float th = 1.0f - 2.0f / (e + 1.0f); return 0.5f * v * (1.0f + th); }

__device__ __forceinline__ int t5_bucket(int rel) {
    const int n = rel < 0 ? -rel : rel; int b;
    if (n < 8) b = n; else b = 8 + (n >= 12) + (n >= 16) + (n >= 23) + (n >= 32) + (n >= 46) + (n >= 64) + (n >= 91);
    return b + (rel > 0 ? 16 : 0);
}

__device__ __forceinline__ void p0_transpose_item(const float* W, int ldw, bf16* WT, int ldt, int k0, int n0src, int n0dst, int k0dst, float* scr, int lane) {
#pragma unroll 8
    for (int i = 0; i < 32; ++i) { const int kk = 2 * i + (lane >> 5); scr[kk * 33 + (lane & 31)] = W[(size_t)(k0 + kk) * ldw + n0src + (lane & 31)]; }
    __builtin_amdgcn_s_waitcnt(0); asm volatile("" ::: "memory");
    const int cch = lane & 7;
#pragma unroll
    for (int j = 0; j < 4; ++j) { const int n = (lane >> 3) + 8 * j; const float* s = scr + (8 * cch) * 33 + n;
        v4u o; o.x = pk2(s[0 * 33], s[1 * 33]); o.y = pk2(s[2 * 33], s[3 * 33]); o.z = pk2(s[4 * 33], s[5 * 33]); o.w = pk2(s[6 * 33], s[7 * 33]);
        *(v4u*)(WT + (size_t)(n0dst + n) * ldt + k0dst + k0 + 8 * cch) = o; }
    __builtin_amdgcn_s_waitcnt(0); asm volatile("" ::: "memory");
}
struct cplx { double re, im; };
__device__ __forceinline__ cplx cmul(cplx a, cplx b) { return {a.re * b.re - a.im * b.im, a.re * b.im + a.im * b.re}; }

__device__ __forceinline__ void p0_prologue(const Ctx& c, int gw, int NGW, int lane, float* scr) {
    {
        constexpr int I_IN = 16 * 224, I_GLU = 8 * 32, I_MKV = 16 * 32, I_BR = 8 * 32, I_OUT = 16 * 32;
        constexpr int NIT = I_IN + I_GLU + I_MKV + 3 * I_BR + I_OUT;
        for (int it = gw; it < NIT; it += NGW) {
            int r = it;
            if (r < I_IN) { const int kb = r / 224, nb = r % 224; p0_transpose_item(c.w_in, DIN, WSP(bf16, WS_WINT), 1024, 64 * kb, 32 * nb, 32 * nb, 0, scr, lane); continue; } r -= I_IN;
            if (r < I_GLU) { const int kb = r / 32, nb = r % 32;
                const int nd = 32 * nb, pn = nd >> 8, bj = (nd >> 7) & 1, j = nd & 127;
                p0_transpose_item(c.w_glu, 1024, WSP(bf16, WS_WGLUT), 512, 64 * kb, 512 * bj + 128 * pn + j, nd, 0, scr, lane); continue; } r -= I_GLU;
            if (r < I_MKV) { const int kb = r / 32, nb = r % 32; p0_transpose_item(c.w_mem_kv, 1024, WSP(bf16, WS_WMKVT), 1024, 64 * kb, 32 * nb, 32 * nb, 0, scr, lane); continue; } r -= I_MKV;
            if (r < 3 * I_BR) { const int s = r / I_BR, rr = r % I_BR, kb = rr / 32, nb = rr % 32; const float* W = s == 0 ? c.w_br_ssm : (s == 1 ? c.w_br_diff : c.w_br_mem);
                p0_transpose_item(W, 1024, WSP(bf16, WS_WBRT), 1536, 64 * kb, 32 * nb, 32 * nb, 512 * s, scr, lane); continue; } r -= 3 * I_BR;
            { const int kb = r / 32, nb = r % 32; p0_transpose_item(c.w_out, 1024, WSP(bf16, WS_WOUTT), 1024, 64 * kb, 32 * nb, 32 * nb, 0, scr, lane); }
        }
    }
    {
        const size_t n8 = (size_t)T * DM / 8; bf16* XB = DOP(bf16, DO_XB);
        for (size_t i = (size_t)gw * 64 + lane; i < n8; i += (size_t)NGW * 64) { const f32x4 a = ((const f32x4*)c.x)[2 * i], b = ((const f32x4*)c.x)[2 * i + 1];
            v4u o; o.x = pk2(a.x, a.y); o.y = pk2(a.z, a.w); o.z = pk2(b.x, b.y); o.w = pk2(b.z, b.w); ((v4u*)XB)[i] = o; }
        const size_t m8 = (size_t)NB * NMEM * DM / 8; bf16* MB = DOP(bf16, DO_MEMB);
        for (size_t i = (size_t)gw * 64 + lane; i < m8; i += (size_t)NGW * 64) { const f32x4 a = ((const f32x4*)c.mem)[2 * i], b = ((const f32x4*)c.mem)[2 * i + 1];
            v4u o; o.x = pk2(a.x, a.y); o.y = pk2(a.z, a.w); o.z = pk2(b.x, b.y); o.w = pk2(b.z, b.w); ((v4u*)MB)[i] = o; }
    }
    {
        bf16* TGC = DOP(bf16, DO_TGC); bf16* WG = DOP(bf16, DO_WG); bf16* GG = DOP(bf16, DO_GG); float* LP = WSP(float, WS_LP);
        float* m1re = scr; float* m1im = scr + 1024;
        for (int it = gw; it < NG * 65; it += NGW) {
            const int g = it / 65, d = it % 65, p = lane;
            const double dt = exp((double)c.log_dt[g]); const double lr = c.lam_re[g * NP + p], li = c.lam_im[g * NP + p];
            const double er = exp(lr * dt * d); const cplx E = {er * cos(li * dt * d), er * sin(li * dt * d)};
            if (d <= 63) {
                const double e1 = exp(lr * dt); const cplx lb = {e1 * cos(li * dt), e1 * sin(li * dt)};
                const double den = lr * lr + li * li; const cplx num = {lb.re - 1.0, lb.im}; const cplx coef = {(num.re * lr + num.im * li) / den, (num.im * lr - num.re * li) / den};
                const cplx EC = cmul(E, coef);
#pragma unroll
                for (int h = 0; h < 16; ++h) { const cplx bb = {c.b_re[(g * NP + p) * 16 + h], c.b_im[(g * NP + p) * 16 + h]}; const cplx m = cmul(EC, bb);
                    m1re[p * 16 + h] = (float)m.re; m1im[p * 16 + h] = (float)m.im;
                    const int j = 63 - d; WG[((size_t)g * 128 + p) * 1024 + j * 16 + h] = (bf16)f2bf((float)m.re); WG[((size_t)g * 128 + 64 + p) * 1024 + j * 16 + h] = (bf16)f2bf((float)m.im); }
                __builtin_amdgcn_s_waitcnt(0); asm volatile("" ::: "memory");
                const int h = lane >> 2, h0 = 4 * (lane & 3); float a0 = 0.f, a1 = 0.f, a2 = 0.f, a3 = 0.f;
                for (int pp = 0; pp < NP; ++pp) { const float cr = c.c_re[(g * 16 + h) * NP + pp], ci = c.c_im[(g * 16 + h) * NP + pp];
                    a0 += cr * m1re[pp * 16 + h0] - ci * m1im[pp * 16 + h0]; a1 += cr * m1re[pp * 16 + h0 + 1] - ci * m1im[pp * 16 + h0 + 1];
                    a2 += cr * m1re[pp * 16 + h0 + 2] - ci * m1im[pp * 16 + h0 + 2]; a3 += cr * m1re[pp * 16 + h0 + 3] - ci * m1im[pp * 16 + h0 + 3]; }
                bf16* dst = TGC + (((size_t)g * 16 + h) * 127 + (63 - d)) * 16 + h0;
                dst[0] = (bf16)f2bf(a0); dst[1] = (bf16)f2bf(a1); dst[2] = (bf16)f2bf(a2); dst[3] = (bf16)f2bf(a3);
                __builtin_amdgcn_s_waitcnt(0); asm volatile("" ::: "memory");
            }
            if (d >= 1) { const int i = d - 1;
#pragma unroll
                for (int h = 0; h < 16; ++h) { const cplx cc = {c.c_re[(g * 16 + h) * NP + p], c.c_im[(g * 16 + h) * NP + p]}; const cplx m = cmul(cc, E);
                    GG[((size_t)g * 1024 + i * 16 + h) * 128 + p] = (bf16)f2bf((float)m.re); GG[((size_t)g * 1024 + i * 16 + h) * 128 + 64 + p] = (bf16)f2bf((float)(-m.im)); } }
            if (d == 64) { LP[(g * NP + p) * 2] = (float)E.re; LP[(g * NP + p) * 2 + 1] = (float)E.im; }
        }
        for (int i = gw * 64 + lane; i < NG * 16 * 63 * 16; i += NGW * 64) { const int hh = i & 15, m = 64 + (i >> 4) % 63, gh = (i >> 4) / 63; TGC[((size_t)gh * 127 + m) * 16 + hh] = 0; }
        for (int i = gw * 64 + lane; i < 4096; i += NGW * 64) GG[(size_t)NG * 1024 * 128 + i] = 0;
    }
    if (gw == 0) {
        float a = c.lq1[lane] * c.lk1[lane], b = c.lq2[lane] * c.lk2[lane];
        for (int o = 1; o < 64; o <<= 1) { a += __shfl_xor(a, o); b += __shfl_xor(b, o); }
        float* SC = WSP(float, WS_SC);
        if (lane == 0) SC[0] = expf(a) - expf(b) + LAMBDA_INIT;
        for (int i = lane; i < 4 * 256; i += 64) { const int h = i >> 8, rel = (i & 255) - 191; SC[256 + i] = c.rel_bias[t5_bucket(rel) * 4 + h] * LOG2E; }
    }
}
__global__ void __launch_bounds__(512) k_p0(Ctx c) {
    extern __shared__ __attribute__((aligned(16))) unsigned char lds[];
    const int lane = threadIdx.x & 63, wave = threadIdx.x >> 6;
    p0_prologue(c, blockIdx.x * 8 + wave, gridDim.x * 8, lane, (float*)(lds + wave * 16384));
}

__device__ __forceinline__ void p1_store(const Ctx& c, int row, int col, float v) {
    const int seg = col >> 9, cc = col & 511;
    if (seg >= 8) { WSP(bf16, WS_GT)[(size_t)row * 3072 + (col - 4096)] = (bf16)f2bf(sigmoidf_(v)); return; }
    if (seg == 0) { WSP(bf16, WS_UG)[(((size_t)(cc >> 4) * NCOL + (row >> 6)) * 64 + (row & 63)) * 16 + (cc & 15)] = (bf16)f2bf(v); return; }
    float o = v;
    if (seg == 1 || seg == 5 || seg == 7) o = siluf_(v); else if (seg == 2) o = v * QS_DIFF; else if (seg == 6) o = v * QS_MEM;
    WSP(bf16, WS_PROJ + (size_t)seg * SEGB)[(size_t)row * 512 + cc] = (bf16)f2bf(o);
}
enum { NM_P1 = 0, NM_MKV = 1, NM_GLU = 2, NM_MERGE = 3, NM_OUT = 4 };
template <int MODE> __global__ void __launch_bounds__(256) nk_gemm(Ctx c, const bf16* A, int lda, const bf16* Bt, int ldb, int K, int nseg) {
    __shared__ float As[64][33], Bs[64][33];
    const int tid = threadIdx.x, tx = tid & 15, ty = tid >> 4, row0 = blockIdx.y * 64, col0 = blockIdx.x * 64;
    float tot[4][4] = {};
    for (int seg = 0; seg < nseg; ++seg) {
        float acc[4][4] = {};
        const bf16* Aseg = A; int koff = 0;
        if (MODE == NM_MERGE) { Aseg = seg == 0 ? WSP(bf16, WS_YS) : (seg == 1 ? WSP(bf16, WS_YD) : DOP(bf16, DO_YM)); koff = 512 * seg; }
        for (int k0 = 0; k0 < K; k0 += 32) {
            for (int i = tid; i < 64 * 32; i += 256) { const int r = i >> 5, kk = i & 31; As[r][kk] = bf2f(Aseg[(size_t)(row0 + r) * lda + k0 + kk]); Bs[r][kk] = bf2f(Bt[(size_t)(col0 + r) * ldb + koff + k0 + kk]); }
            __syncthreads();
#pragma unroll 8
            for (int kk = 0; kk < 32; ++kk) {
                float a[4], b[4];
#pragma unroll
                for (int i = 0; i < 4; ++i) { a[i] = As[ty * 4 + i][kk]; b[i] = Bs[tx * 4 + i][kk]; }
#pragma unroll
                for (int i = 0; i < 4; ++i)
#pragma unroll
                    for (int j = 0; j < 4; ++j) acc[i][j] += a[i] * b[j];
            }
            __syncthreads();
        }
#pragma unroll
        for (int i = 0; i < 4; ++i)
#pragma unroll
            for (int j = 0; j < 4; ++j) { const int row = row0 + ty * 4 + i, col = col0 + tx * 4 + j;
                if (MODE == NM_MERGE) tot[i][j] += acc[i][j] * bf2f(WSP(bf16, WS_GT)[(size_t)row * 3072 + seg * 1024 + col]); else tot[i][j] = acc[i][j]; }
    }
#pragma unroll
    for (int i = 0; i < 4; ++i)
#pragma unroll
        for (int j = 0; j < 4; ++j) {
            const int row = row0 + ty * 4 + i, col = col0 + tx * 4 + j; const float v = tot[i][j];
            if (MODE == NM_P1) p1_store(c, row, col, v);
            else if (MODE == NM_MKV) { if (col < 512) DOP(bf16, DO_MK)[(size_t)row * 512 + col] = (bf16)f2bf(v); else DOP(bf16, DO_MV)[(size_t)row * 512 + col - 512] = (bf16)f2bf(v); }
            else if (MODE == NM_MERGE) WSP(bf16, WS_MG)[(size_t)row * 1024 + col] = (bf16)f2bf(v);
            else if (MODE == NM_OUT) c.out[(size_t)row * 1024 + col] = ALPHA * c.x[(size_t)row * 1024 + col] + v;
        }
}
__global__ void __launch_bounds__(256) nk_glu(Ctx c) {
    __shared__ float As[64][33], Bv[64][33], Bg[64][33];
    const int tid = threadIdx.x, tx = tid & 15, ty = tid >> 4, row0 = blockIdx.y * 64, ch0 = blockIdx.x * 64;
    const bf16* A = DOP(bf16, DO_VB); const bf16* Bt = WSP(bf16, WS_WGLUT);
    const int nv0 = 256 * (ch0 >> 7) + (ch0 & 127), ng0 = nv0 + 128;
    float av[4][4] = {}, ag[4][4] = {};
    for (int k0 = 0; k0 < 512; k0 += 32) {
        for (int i = tid; i < 64 * 32; i += 256) { const int r = i >> 5, kk = i & 31; As[r][kk] = bf2f(A[(size_t)(row0 + r) * 512 + k0 + kk]);
            Bv[r][kk] = bf2f(Bt[(size_t)(nv0 + r) * 512 + k0 + kk]); Bg[r][kk] = bf2f(Bt[(size_t)(ng0 + r) * 512 + k0 + kk]); }
        __syncthreads();
        for (int kk = 0; kk < 32; ++kk) {
            float a[4], b[4], g[4];
#pragma unroll
            for (int i = 0; i < 4; ++i) { a[i] = As[ty * 4 + i][kk]; b[i] = Bv[tx * 4 + i][kk]; g[i] = Bg[tx * 4 + i][kk]; }
#pragma unroll
            for (int i = 0; i < 4; ++i)
#pragma unroll
                for (int j = 0; j < 4; ++j) { av[i][j] += a[i] * b[j]; ag[i][j] += a[i] * g[j]; }
        }
        __syncthreads();
    }
#pragma unroll
    for (int i = 0; i < 4; ++i)
#pragma unroll
        for (int j = 0; j < 4; ++j) { const int row = row0 + ty * 4 + i, ch = ch0 + tx * 4 + j; const size_t off = (size_t)row * 512 + ch;
            WSP(bf16, WS_YS)[off] = (bf16)f2bf(av[i][j] * sigmoidf_(ag[i][j]) * bf2f(WSP(bf16, WS_ZS)[off])); }
}
__global__ void __launch_bounds__(64) nk_s5(Ctx c) {
    __shared__ float sm[16][65];
    const int b = blockIdx.x / NG, g = blockIdx.x % NG, p = threadIdx.x, lane = p;
    const float dt = expf(c.log_dt[g]), lr = c.lam_re[g * NP + p], li = c.lam_im[g * NP + p];
    const float e1 = expf(lr * dt), lbr = e1 * cosf(li * dt), lbi = e1 * sinf(li * dt);
    const float den = lr * lr + li * li, nr = lbr - 1.0f, ni = lbi, cfr = (nr * lr + ni * li) / den, cfi = (ni * lr - nr * li) / den;
    float Br[16], Bi[16], Cr[16], Ci[16];
#pragma unroll
    for (int h = 0; h < 16; ++h) { const float br = c.b_re[(g * NP + p) * 16 + h], bi = c.b_im[(g * NP + p) * 16 + h]; Br[h] = cfr * br - cfi * bi; Bi[h] = cfr * bi + cfi * br;
        Cr[h] = c.c_re[(g * 16 + h) * NP + p]; Ci[h] = c.c_im[(g * 16 + h) * NP + p]; }
    const bf16* UG = WSP(bf16, WS_UG); bf16* VB = DOP(bf16, DO_VB);
    float sr = 0.f, si = 0.f;
    const int hq = lane >> 2, q = lane & 3; const float dsk = c.d_skip[g * 16 + hq];
    for (int t = 0; t < SEQ; ++t) {
        const bf16* up = UG + (((size_t)g * NCOL + (b * 64 + (t >> 6))) * 64 + (t & 63)) * 16;
        float u[16];
#pragma unroll
        for (int h = 0; h < 16; ++h) u[h] = bf2f(up[h]);
        float bur = 0.f, bui = 0.f;
#pragma unroll
        for (int h = 0; h < 16; ++h) { bur += Br[h] * u[h]; bui += Bi[h] * u[h]; }
        const float nsr = lbr * sr - lbi * si + bur, nsi = lbr * si + lbi * sr + bui; sr = nsr; si = nsi;
#pragma unroll
        for (int h = 0; h < 16; ++h) sm[h][p] = Cr[h] * sr - Ci[h] * si;
        __builtin_amdgcn_s_waitcnt(0); asm volatile("" ::: "memory");
        float y = 0.f;
#pragma unroll
        for (int k = 0; k < 16; ++k) y += sm[hq][q * 16 + k];
        y += __shfl_xor(y, 1); y += __shfl_xor(y, 2);
        if (q == 0) VB[(size_t)(b * SEQ + t) * 512 + g * 16 + hq] = (bf16)f2bf(gelu_tanh(y + dsk * u[hq]));
        __builtin_amdgcn_s_waitcnt(0); asm volatile("" ::: "memory");
    }
}
template <bool DIFF> __global__ void __launch_bounds__(256) nk_attn(Ctx c) {
    extern __shared__ __attribute__((aligned(16))) unsigned char lds[];
    float* Qs = (float*)lds;
    float* Ks = Qs + 64 * 129;
    float* Vs = Ks + 32 * 129;
    float* Ps = Vs + 32 * 132;
    const int tid = threadIdx.x, row = tid >> 2, kq = tid & 3;
    const int qc = blockIdx.x & 63, h = (blockIdx.x >> 6) & 3, b = blockIdx.x >> 8;
    const int q0 = qc * 64; const size_t tok0 = (size_t)b * SEQ + q0;
    bf16* Qg = WSP(bf16, DIFF ? WS_DQ : WS_MQ); const bf16* Kg = DIFF ? WSP(bf16, WS_DK) : DOP(bf16, DO_MK); const bf16* Vg = DIFF ? WSP(bf16, WS_DV) : DOP(bf16, DO_MV);
    const size_t kbase = DIFF ? (size_t)b * SEQ : (size_t)b * NMEM;
    const float* BT = WSP(float, WS_SC) + 256 + h * 256;
    for (int i = tid; i < 64 * 128; i += 256) Qs[(i >> 7) * 129 + (i & 127)] = bf2f(Qg[(tok0 + (i >> 7)) * 512 + h * 128 + (i & 127)]);
    constexpr int NMAP = DIFF ? 2 : 1, DQK = DIFF ? 64 : 128;
    float m[NMAP], l[NMAP], o[NMAP][32];
#pragma unroll
    for (int mp = 0; mp < NMAP; ++mp) { m[mp] = -1e30f; l[mp] = 0.f;
#pragma unroll
        for (int i = 0; i < 32; ++i) o[mp][i] = 0.f; }
    const int ntile = DIFF ? 2 * (qc + 1) : NMEM / 32;
    for (int kt = 0; kt < ntile; ++kt) {
        __syncthreads();
        for (int i = tid; i < 32 * 128; i += 256) { const size_t r = kbase + kt * 32 + (i >> 7); Ks[(i >> 7) * 129 + (i & 127)] = bf2f(Kg[r * 512 + h * 128 + (i & 127)]); Vs[(i >> 7) * 132 + ((i & 127) >> 5) * 33 + (i & 31)] = bf2f(Vg[r * 512 + h * 128 + (i & 127)]); }
        __syncthreads();
#pragma unroll
        for (int mp = 0; mp < NMAP; ++mp) {
            float s[8]; float mx = -1e30f;
#pragma unroll
            for (int j = 0; j < 8; ++j) { const int kk = kq * 8 + j; float a = 0.f;
                for (int d = 0; d < DQK; ++d) a += Qs[row * 129 + mp * DQK + d] * Ks[kk * 129 + mp * DQK + d];
                if (DIFF) { const int rel = (kt * 32 + kk) - (q0 + row); a += rel >= -191 ? BT[rel + 191] : BT[0]; }
                s[j] = a; mx = fmaxf(mx, a); }
            mx = fmaxf(mx, __shfl_xor(mx, 1)); mx = fmaxf(mx, __shfl_xor(mx, 2));
            const float mn = fmaxf(m[mp], mx), al = exp2f(m[mp] - mn); m[mp] = mn; float ps = 0.f;
#pragma unroll
            for (int j = 0; j < 8; ++j) { const float pv = exp2f(s[j] - mn); ps += pv; Ps[(mp * 64 + row) * 33 + kq * 8 + j] = pv; }
            ps += __shfl_xor(ps, 1); ps += __shfl_xor(ps, 2);
            l[mp] = l[mp] * al + ps;
#pragma unroll
            for (int i = 0; i < 32; ++i) o[mp][i] *= al;
        }
        __syncthreads();
#pragma unroll
        for (int mp = 0; mp < NMAP; ++mp)
            for (int kk = 0; kk < 32; ++kk) { const float pv = Ps[(mp * 64 + row) * 33 + kk];
#pragma unroll
                for (int i = 0; i < 32; ++i) o[mp][i] += pv * Vs[kk * 132 + kq * 33 + i]; }
    }
    __syncthreads();
    if (DIFF) {
        const float lam = WSP(float, WS_SC)[0]; const float i0 = 1.0f / l[0], i1 = lam / l[NMAP - 1]; float ss = 0.f; float r[32];
#pragma unroll
        for (int i = 0; i < 32; ++i) { r[i] = o[0][i] * i0 - o[NMAP - 1][i] * i1; ss += r[i] * r[i]; }
        ss += __shfl_xor(ss, 1); ss += __shfl_xor(ss, 2);
        const float rs = rsqrtf(ss * (1.0f / 128.0f) + RMS_EPS) * (1.0f - LAMBDA_INIT);
#pragma unroll
        for (int i = 0; i < 32; ++i) { const int d = kq * 32 + i; const size_t idx = (tok0 + row) * 512 + h * 128 + d;
            WSP(bf16, WS_YD)[idx] = (bf16)f2bf(r[i] * rs * c.subln[d] * bf2f(WSP(bf16, WS_ZD)[idx])); }
    } else {
        const float i0 = 1.0f / l[0];
#pragma unroll
        for (int i = 0; i < 32; ++i) { const int d = kq * 32 + i; const size_t idx = (tok0 + row) * 512 + h * 128 + d;
            DOP(bf16, DO_YM)[idx] = (bf16)f2bf(o[0][i] * i0 * bf2f(WSP(bf16, WS_ZM)[idx])); }
    }
}
__device__ __forceinline__ void ln_rows(const Ctx& c, int gw, int NGW, int lane, float* dst) {
    for (int r = gw; r < T; r += NGW) {
        f32x4* rp = (f32x4*)(c.out + (size_t)r * DM) + lane; f32x4* wp = (f32x4*)(dst + (size_t)r * DM) + lane; f32x4 v[4]; float s = 0.f;
#pragma unroll
        for (int j = 0; j < 4; ++j) { v[j] = rp[64 * j]; s += (v[j].x + v[j].y) + (v[j].z + v[j].w); }
        for (int o = 1; o < 64; o <<= 1) s += __shfl_xor(s, o);
        const float mean = s * (1.0f / DM); float s2 = 0.f;
#pragma unroll
        for (int j = 0; j < 4; ++j) { v[j] = v[j] - mean; s2 += (v[j].x * v[j].x + v[j].y * v[j].y) + (v[j].z * v[j].z + v[j].w * v[j].w); }
        for (int o = 1; o < 64; o <<= 1) s2 += __shfl_xor(s2, o);
        const float rstd = rsqrtf(s2 * (1.0f / DM) + LN_EPS);
#pragma unroll
        for (int j = 0; j < 4; ++j) { const f32x4 g = ((const f32x4*)c.ln_g)[lane + 64 * j], bb = ((const f32x4*)c.ln_b)[lane + 64 * j]; wp[64 * j] = v[j] * rstd * g + bb; }
    }
}
__global__ void __launch_bounds__(256) k_ln(Ctx c) { ln_rows(c, blockIdx.x * 4 + (threadIdx.x >> 6), gridDim.x * 4, threadIdx.x & 63, c.out); }


namespace pg8 {
#define PG8_LAS __attribute__((address_space(3)))
typedef short bf16x8 __attribute__((ext_vector_type(8)));
typedef unsigned u32x4 __attribute__((ext_vector_type(4)));
constexpr int BM = 256, BK = 64, HALF = 128, HTB = HALF * BK * 2, STAGE_BYTES = 8 * HTB, NXCD = 8, WGM = 8;
__host__ __device__ __forceinline__ int lds_byte(int r, int c) { const int st = (r >> 4) * 2 + (c >> 5), rr = r & 15, cc = c & 31, ob = rr * 64 + cc * 2; return st * 1024 + (ob ^ (((ob >> 9) & 1) << 5)); }
__host__ __device__ __forceinline__ void stage_rc(int b, int& R, int& C) { const int st = b / 1024, sb = b % 1024, swz = sb ^ (((sb >> 9) & 1) << 5); R = (st >> 1) * 16 + swz / 64; C = (st & 1) * 32 + (swz % 64) / 2; }
__host__ __device__ __forceinline__ int perm32(int rho) { const int n = rho >> 4, i = rho & 15; return 8 * (i >> 2) + 4 * n + (i & 3); }
__device__ __forceinline__ unsigned cvt_pk_bf16(float lo, float hi) { unsigned r; asm volatile("v_cvt_pk_bf16_f32 %0, %1, %2" : "=v"(r) : "v"(lo), "v"(hi)); return r; }

struct GUnit { const char* A; const char* B; int nt, pm, pn, seg, last, cfg, aux; };
struct LoadCfg { unsigned voffA[2][2], voffB[2][2]; long hsA[2], hsB[2]; };
__device__ __forceinline__ void voff_plain(unsigned (&v)[2], int ld, bool perm) {
#pragma unroll
    for (int i = 0; i < 2; ++i) { int R, C; stage_rc(threadIdx.x * 16 + i * 8192, R, C); const int Rb = perm ? ((R & ~31) + perm32(R & 31)) : R; v[i] = (unsigned)(Rb * ld + C) * 2u; }
}
__device__ __forceinline__ bool tile_order(int nM, int nN, int G, int c, int i, int& pm, int& pn) {
    const int nwg = nM * nN; const long L = (long)i * G + c; if (L >= nwg) return false;
    int wgid = (int)L; { const int q = nwg / NXCD, r = nwg % NXCD, xcd = wgid % NXCD, off = wgid / NXCD; wgid = (xcd < r ? xcd * (q + 1) : r * (q + 1) + (xcd - r) * q) + off; }
    const int nig = WGM * nN, gid = wgid / nig, fm = gid * WGM, gsz = (nM - fm) < WGM ? (nM - fm) : WGM;
    pm = fm + ((wgid % nig) % gsz); pn = (wgid % nig) / gsz; return true;
}
template <class Epi, class Sched, bool ALIGN_EPI, bool SP2, int NCFG = 1>
__device__ __forceinline__ void gemm_phase(PG8_LAS unsigned char* lds, const LoadCfg& L, const Sched& S, const Epi& E) {
    const int tid = threadIdx.x, wid = __builtin_amdgcn_readfirstlane(tid >> 6), lane = tid & 63, wr = wid >> 2, wc = wid & 3, fr = lane & 15, fq = lane >> 4;
    const size_t kstep = (size_t)(BK * 2);
    const unsigned ldsw = (unsigned)wid * 1024u;
    const int aoff = lds_byte(wr * 64 + fr, fq * 8), boff = lds_byte(wc * 32 + fr, fq * 8);
#define PG8_SA(b, h) (((b) * 2 + (h)) * HTB)
#define PG8_SB(b, h) ((4 + (b) * 2 + (h)) * HTB)
#define PG8_STAGE(bufoff, gbase, voff) do { _Pragma("unroll") for (int _i = 0; _i < 2; ++_i) \
        __builtin_amdgcn_global_load_lds((const unsigned*)((const char*)(gbase) + (voff)[_i]), (PG8_LAS unsigned*)(lds + (bufoff) + ldsw + _i * 8192), 16, 0, 0); } while (0)
#define PG8_LDA(dst, b, h) do { _Pragma("unroll") for (int m = 0; m < 4; ++m) _Pragma("unroll") for (int k = 0; k < 2; ++k) dst[m][k] = *(const PG8_LAS bf16x8*)(lds + PG8_SA(b, h) + aoff + m * 2048 + k * 1024); } while (0)
#define PG8_LDB(dst, b, h) do { _Pragma("unroll") for (int n = 0; n < 2; ++n) _Pragma("unroll") for (int k = 0; k < 2; ++k) dst[n][k] = *(const PG8_LAS bf16x8*)(lds + PG8_SB(b, h) + boff + n * 2048 + k * 1024); } while (0)
#define PG8_MMA(ai, bj, At, Bt) do { __builtin_amdgcn_s_setprio(1); _Pragma("unroll") for (int m = 0; m < 4; ++m) _Pragma("unroll") for (int n = 0; n < 2; ++n) _Pragma("unroll") for (int k = 0; k < 2; ++k) \
        acc[ai][bj][m][n] = __builtin_amdgcn_mfma_f32_16x16x32_bf16(Bt[n][k], At[m][k], acc[ai][bj][m][n], 0, 0, 0); __builtin_amdgcn_s_setprio(0); } while (0)
#define PG8_WAIT_V(n) asm volatile("s_waitcnt vmcnt(" #n ")" ::: "memory")
#define PG8_WAIT_L(n) asm volatile("s_waitcnt lgkmcnt(" #n ")" ::: "memory")
#define PG8_BAR __builtin_amdgcn_s_barrier()
#define PG8_SCHED __builtin_amdgcn_sched_barrier(0)
    GUnit cur, nxt; int ui = 0;
    if (!S.next(0, cur)) return;
    f32x4 acc[2][2][4][2];
#pragma unroll
    for (int a = 0; a < 2; ++a)
#pragma unroll
        for (int b = 0; b < 2; ++b)
#pragma unroll
            for (int m = 0; m < 4; ++m)
#pragma unroll
                for (int n = 0; n < 2; ++n) acc[a][b][m][n] = (f32x4){0.f, 0.f, 0.f, 0.f};
    bf16x8 At[4][2], B0[2][2], B1[2][2];
    const char* cA = cur.A; const char* cB = cur.B;
    static_assert(SP2, "only the two-super-phase loop is kept here");
#define PG8_CFG(u) ((NCFG == 1) ? 0 : (u).cfg)
#define PG8_SELV(dst, src, cf) do { dst[0] = (NCFG == 1 || (cf) == 0) ? src[0][0] : src[1][0]; dst[1] = (NCFG == 1 || (cf) == 0) ? src[0][1] : src[1][1]; } while (0)
    unsigned vAc[2], vBc[2]; long hsA, hsB;
    { const int cf = PG8_CFG(cur); PG8_SELV(vAc, L.voffA, cf); PG8_SELV(vBc, L.voffB, cf); hsA = (NCFG == 1 || cf == 0) ? L.hsA[0] : L.hsA[1]; hsB = (NCFG == 1 || cf == 0) ? L.hsB[0] : L.hsB[1]; }
    PG8_STAGE(PG8_SB(0, 0), cB, vBc); PG8_STAGE(PG8_SB(0, 1), cB + hsB, vBc); PG8_STAGE(PG8_SA(0, 0), cA, vAc); PG8_STAGE(PG8_SA(0, 1), cA + hsA, vAc);
    if (wr == 1) PG8_BAR;
    PG8_WAIT_V(2); PG8_BAR;
    PG8_STAGE(PG8_SB(1, 0), cB + kstep, vBc); PG8_STAGE(PG8_SA(1, 0), cA + kstep, vAc); PG8_STAGE(PG8_SB(1, 1), cB + hsB + kstep, vBc);
    PG8_WAIT_V(6); PG8_BAR;
    for (;;) {
        const bool has_next = S.next(ui + 1, nxt);
        const char* nA = has_next ? nxt.A : cA; const char* nB = has_next ? nxt.B : cB;
        unsigned vAn[2], vBn[2]; long hsAn, hsBn;
        { const int cf = has_next ? PG8_CFG(nxt) : PG8_CFG(cur); PG8_SELV(vAn, L.voffA, cf); PG8_SELV(vBn, L.voffB, cf); hsAn = (NCFG == 1 || cf == 0) ? L.hsA[0] : L.hsA[1]; hsBn = (NCFG == 1 || cf == 0) ? L.hsB[0] : L.hsB[1]; }
        const int nt = cur.nt;
        for (int t = 0; t < nt; t += 2) {
            const bool last = (t == nt - 2);
            const char* a1 = cA + (size_t)(t + 1) * kstep;
            const char* a2 = last ? nA : cA + (size_t)(t + 2) * kstep; const char* b2 = last ? nB : cB + (size_t)(t + 2) * kstep;
            const char* a3 = a2 + kstep; const char* b3 = b2 + kstep;
            unsigned vA2[2], vB2[2]; long hA2, hB2;
            if (NCFG == 1) { vA2[0] = vAc[0]; vA2[1] = vAc[1]; vB2[0] = vBc[0]; vB2[1] = vBc[1]; hA2 = hsA; hB2 = hsB; }
            else { vA2[0] = last ? vAn[0] : vAc[0]; vA2[1] = last ? vAn[1] : vAc[1]; vB2[0] = last ? vBn[0] : vBc[0]; vB2[1] = last ? vBn[1] : vBc[1]; hA2 = last ? hsAn : hsA; hB2 = last ? hsBn : hsB; }
            PG8_LDB(B0, 0, 0); PG8_LDB(B1, 0, 1); PG8_SCHED; PG8_LDA(At, 0, 0); PG8_STAGE(PG8_SA(1, 1), a1 + hsA, vAc);
            PG8_WAIT_V(8); PG8_WAIT_L(0); PG8_BAR; PG8_MMA(0, 0, At, B0); PG8_MMA(0, 1, At, B1); PG8_BAR; PG8_SCHED;
            PG8_LDA(At, 0, 1); PG8_STAGE(PG8_SB(0, 0), b2, vB2); PG8_STAGE(PG8_SB(0, 1), b2 + hB2, vB2); PG8_STAGE(PG8_SA(0, 0), a2, vA2);
            PG8_WAIT_V(8); PG8_WAIT_L(0); PG8_BAR; PG8_MMA(1, 0, At, B0); PG8_MMA(1, 1, At, B1); PG8_BAR; PG8_SCHED;
            PG8_LDB(B0, 1, 0); PG8_LDB(B1, 1, 1); PG8_SCHED; PG8_LDA(At, 1, 0); PG8_STAGE(PG8_SA(0, 1), a2 + hA2, vA2);
            PG8_WAIT_V(8); PG8_WAIT_L(0); PG8_BAR; PG8_MMA(0, 0, At, B0); PG8_MMA(0, 1, At, B1); PG8_BAR; PG8_SCHED;
            PG8_LDA(At, 1, 1); PG8_STAGE(PG8_SB(1, 0), b3, vB2); PG8_STAGE(PG8_SB(1, 1), b3 + hB2, vB2); PG8_STAGE(PG8_SA(1, 0), a3, vA2);
            PG8_WAIT_V(8); PG8_WAIT_L(0); PG8_BAR; PG8_MMA(1, 0, At, B0); PG8_MMA(1, 1, At, B1); PG8_BAR; PG8_SCHED;
        }
        if constexpr (ALIGN_EPI) { if (wr == 0) PG8_BAR; }
        E(acc, cur, wr, wc, fr, fq);
        if (!has_next) break;
        if (cur.last) {
#pragma unroll
            for (int a = 0; a < 2; ++a)
#pragma unroll
                for (int b = 0; b < 2; ++b)
#pragma unroll
                    for (int m = 0; m < 4; ++m)
#pragma unroll
                        for (int n = 0; n < 2; ++n) acc[a][b][m][n] = (f32x4){0.f, 0.f, 0.f, 0.f};
        }
        cur = nxt; cA = nA; cB = nB; ++ui; vAc[0] = vAn[0]; vAc[1] = vAn[1]; vBc[0] = vBn[0]; vBc[1] = vBn[1]; hsA = hsAn; hsB = hsBn;
        if constexpr (ALIGN_EPI) { if (wr == 1) PG8_BAR; }
    }
    PG8_WAIT_V(0);
    if constexpr (!ALIGN_EPI) { if (wr == 0) PG8_BAR; }
    PG8_BAR;
#undef PG8_CFG
#undef PG8_SELV
#undef PG8_SA
#undef PG8_SB
#undef PG8_STAGE
#undef PG8_LDA
#undef PG8_LDB
#undef PG8_MMA
#undef PG8_WAIT_V
#undef PG8_WAIT_L
#undef PG8_BAR
#undef PG8_SCHED
}
}

typedef f32x4 acc_t[2][2][4][2];
__device__ __forceinline__ v4u pack8(const f32x4 a, const f32x4 b) { v4u w; w.x = pg8::cvt_pk_bf16(a[0], a[1]); w.y = pg8::cvt_pk_bf16(a[2], a[3]); w.z = pg8::cvt_pk_bf16(b[0], b[1]); w.w = pg8::cvt_pk_bf16(b[2], b[3]); return w; }
__device__ __forceinline__ void unpack8(const v4u w, f32x4& a, f32x4& b) {
    a[0] = __builtin_bit_cast(float, w.x << 16); a[1] = __builtin_bit_cast(float, w.x & 0xffff0000u); a[2] = __builtin_bit_cast(float, w.y << 16); a[3] = __builtin_bit_cast(float, w.y & 0xffff0000u);
    b[0] = __builtin_bit_cast(float, w.z << 16); b[1] = __builtin_bit_cast(float, w.z & 0xffff0000u); b[2] = __builtin_bit_cast(float, w.w << 16); b[3] = __builtin_bit_cast(float, w.w & 0xffff0000u); }
__device__ __forceinline__ float fast_sigmoid(float v) { return __builtin_amdgcn_rcpf(1.0f + __builtin_amdgcn_exp2f(-LOG2E * v)); }
template <class F> __device__ __forceinline__ f32x4 map4(const f32x4 v, F f) { return (f32x4){f(v[0]), f(v[1]), f(v[2]), f(v[3])}; }


namespace att {
typedef short bf16x8 __attribute__((ext_vector_type(8)));
typedef short s16x4 __attribute__((ext_vector_type(4)));
typedef float f32x16 __attribute__((ext_vector_type(16)));
#define ALAS __attribute__((address_space(3)))
constexpr int SLOT = 32768, L_BT = 98304, L_WSF = 99328;
constexpr float THR = 8.0f;
__device__ __forceinline__ int crow(int r, int hi) { return (r & 3) + 8 * (r >> 2) + 4 * hi; }
__device__ __forceinline__ float swapmax(float m) { auto rr = __builtin_amdgcn_permlane32_swap(__builtin_bit_cast(unsigned, m), __builtin_bit_cast(unsigned, m), false, false); return fmaxf(__builtin_bit_cast(float, rr[0]), __builtin_bit_cast(float, rr[1])); }
__device__ __forceinline__ float swapsum(float m) { auto rr = __builtin_amdgcn_permlane32_swap(__builtin_bit_cast(unsigned, m), __builtin_bit_cast(unsigned, m), false, false); return __builtin_bit_cast(float, rr[0]) + __builtin_bit_cast(float, rr[1]); }
__device__ __forceinline__ s16x4 vtr(const ALAS unsigned char* p) { typedef short v4i16_t __attribute__((ext_vector_type(4))); return __builtin_bit_cast(s16x4, __builtin_amdgcn_ds_read_tr16_b64_v4i16((ALAS v4i16_t*)p)); }
__device__ __forceinline__ void dma_tile(ALAS unsigned char* slot, const bf16* Kg, const bf16* Vg, size_t kvrow, int h, int w, int lane) {
#pragma unroll
    for (int i = 0; i < 2; ++i) { const int pc = w + 8 * i;
        __builtin_amdgcn_global_load_lds((const unsigned*)(Kg + (kvrow + lane) * 512 + h * 128 + pc * 8), (ALAS unsigned*)(slot + pc * 1024), 16, 0, 0); }
#pragma unroll
    for (int i = 0; i < 2; ++i) { const int pc = w + 8 * i, d0 = pc >> 2, kvg = pc & 3;
        __builtin_amdgcn_global_load_lds((const unsigned*)(Vg + (kvrow + 16 * kvg + (lane >> 2)) * 512 + h * 128 + d0 * 32 + (lane & 3) * 8), (ALAS unsigned*)(slot + 16384 + pc * 1024), 16, 0, 0); }
}
template <bool DIFF>
__device__ __forceinline__ void attn_unit(const Ctx& c, ALAS unsigned char* lds, int b, int h, int qb) {
    int tid_ = threadIdx.x; asm volatile("" : "+v"(tid_));
    const int tid = tid_, lane = tid & 63, r32 = lane & 31, hi = lane >> 5, w = __builtin_amdgcn_readfirstlane(tid >> 6);
    constexpr int NDS = DIFF ? 4 : 8, UR = DIFF ? 128 : 256;
    const int mapc = DIFF ? (w >> 2) : 0, wrow = DIFF ? 32 * (w & 3) : 32 * w, q0 = qb * UR;
    const size_t tok0 = (size_t)b * SEQ + q0, kvrow0 = DIFF ? (size_t)b * SEQ : (size_t)b * NMEM;
    bf16* Qg = DIFF ? WSP(bf16, WS_DQ) : WSP(bf16, WS_MQ); const bf16* Kg = DIFF ? WSP(bf16, WS_DK) : DOP(bf16, DO_MK); const bf16* Vg = DIFF ? WSP(bf16, WS_DV) : DOP(bf16, DO_MV);
    const bf16* Zg = DIFF ? WSP(bf16, WS_ZD) : WSP(bf16, WS_ZM); bf16* Og = DIFF ? WSP(bf16, WS_YD) : DOP(bf16, DO_YM);
    const int NT = DIFF ? (q0 + 128) / 64 : 4;
    const int nt_w = DIFF ? ((w & 3) < 2 ? NT - 1 : NT) : NT, near0 = DIFF ? nt_w - 3 : NT;
    ALAS float* bt = (ALAS float*)(lds + L_BT); ALAS float* wsf = (ALAS float*)(lds + L_WSF) + w * 64;
    bf16x8 qr[NDS];
#pragma unroll
    for (int ds = 0; ds < NDS; ++ds) qr[ds] = *(const bf16x8*)(Qg + (tok0 + wrow + r32) * 512 + h * 128 + mapc * 64 + ds * 16 + hi * 8);
    if (DIFF && tid < 256) bt[tid] = WSP(float, WS_SC)[256 + h * 256 + tid];
    const float bfar = DIFF ? WSP(float, WS_SC)[256 + h * 256] : 0.f;
    asm volatile("s_waitcnt vmcnt(0)" ::: "memory");
    dma_tile(lds, Kg, Vg, kvrow0, h, w, lane);
    if (NT > 1) dma_tile(lds + SLOT, Kg, Vg, kvrow0 + 64, h, w, lane);
    f32x16 o[4];
#pragma unroll
    for (int d0 = 0; d0 < 4; ++d0) o[d0] = f32x16{};
    float mref = 0.f, lsum = 0.f;
    const int vb = ((lane >> 4) & 1) * 32 + (lane & 3) * 8 + (4 * hi + ((lane & 15) >> 2)) * 64;
    for (int t = 0; t < NT; ++t) {
        if (t + 1 < NT) asm volatile("s_waitcnt vmcnt(4)" ::: "memory"); else asm volatile("s_waitcnt vmcnt(0)" ::: "memory");
        __builtin_amdgcn_s_barrier(); asm volatile("" ::: "memory");
        if (t + 2 < NT) dma_tile(lds + ((t + 2) % 3) * SLOT, Kg, Vg, kvrow0 + 64 * (t + 2), h, w, lane);
        if (t < nt_w) {
            const ALAS unsigned char* ks = lds + (t % 3) * SLOT; const ALAS unsigned char* vs = ks + 16384;
            const bool nearb = DIFF && t >= near0;
            const float cv = (nearb ? 0.f : bfar) - mref;
            f32x16 p0, p1;
#pragma unroll
            for (int r = 0; r < 16; ++r) { p0[r] = cv; p1[r] = cv; }
            const ALAS unsigned char* kp = ks + (mapc * 8 + hi) * 1024 + r32 * 16;
#pragma unroll
            for (int ds = 0; ds < NDS; ++ds) { const bf16x8 k0 = *(const ALAS bf16x8*)(kp + ds * 2048), k1 = *(const ALAS bf16x8*)(kp + ds * 2048 + 512);
                p0 = __builtin_amdgcn_mfma_f32_32x32x16_bf16(k0, qr[ds], p0, 0, 0, 0); p1 = __builtin_amdgcn_mfma_f32_32x32x16_bf16(k1, qr[ds], p1, 0, 0, 0); }
            if (nearb) { const int ib = 64 * t - q0 - wrow - r32 + 191 + 4 * hi;
#pragma unroll
                for (int r = 0; r < 16; ++r) { p0[r] += bt[ib + (r & 3) + 8 * (r >> 2)]; p1[r] += bt[ib + 32 + (r & 3) + 8 * (r >> 2)]; } }
            float rm = fmaxf(p0[0], p1[0]);
#pragma unroll
            for (int r = 1; r < 16; ++r) rm = fmaxf(rm, fmaxf(p0[r], p1[r]));
            rm = swapmax(rm);
            if (t == 0 || __any(rm > THR)) {
                const float dl = t == 0 ? rm : fmaxf(rm, 0.f); mref += dl;
#pragma unroll
                for (int r = 0; r < 16; ++r) { p0[r] -= dl; p1[r] -= dl; }
                if (t > 0) { const float f = __builtin_amdgcn_exp2f(-dl); lsum *= f; if (hi == 0) wsf[r32] = f;
#pragma unroll
                    for (int r = 0; r < 16; ++r) { const float fr = wsf[crow(r, hi)];
#pragma unroll
                        for (int d0 = 0; d0 < 4; ++d0) o[d0][r] *= fr; } }
            }
            float ps = 0.f;
#pragma unroll
            for (int r = 0; r < 16; ++r) { p0[r] = __builtin_amdgcn_exp2f(p0[r]); p1[r] = __builtin_amdgcn_exp2f(p1[r]); ps += p0[r] + p1[r]; }
            lsum += ps;
            bf16x8 pa[4];
#pragma unroll
            for (int kk = 0; kk < 4; ++kk) { const f32x16& P = (kk < 2) ? p0 : p1; const int r0 = 8 * (kk & 1);
                const v4u pw = {pg8::cvt_pk_bf16(P[r0], P[r0 + 1]), pg8::cvt_pk_bf16(P[r0 + 2], P[r0 + 3]), pg8::cvt_pk_bf16(P[r0 + 4], P[r0 + 5]), pg8::cvt_pk_bf16(P[r0 + 6], P[r0 + 7])};
                pa[kk] = __builtin_bit_cast(bf16x8, pw); }
#pragma unroll
            for (int d0 = 0; d0 < 4; ++d0)
#pragma unroll
                for (int kk = 0; kk < 4; ++kk) { const s16x4 lo = vtr(vs + d0 * 4096 + kk * 1024 + vb), hh = vtr(vs + d0 * 4096 + kk * 1024 + 512 + vb);
                    const bf16x8 vf = {lo[0], lo[1], lo[2], lo[3], hh[0], hh[1], hh[2], hh[3]};
                    o[d0] = __builtin_amdgcn_mfma_f32_32x32x16_bf16(pa[kk], vf, o[d0], 0, 0, 0); }
        }
    }
    lsum = swapsum(lsum);
    asm volatile("s_waitcnt lgkmcnt(0)" ::: "memory"); __builtin_amdgcn_s_barrier(); asm volatile("" ::: "memory");
    if (hi == 0) wsf[32 + r32] = lsum;
    float rl[16];
#pragma unroll
    for (int r = 0; r < 16; ++r) rl[r] = 1.0f / wsf[32 + crow(r, hi)];
    if (DIFF) {
        ALAS float* st1 = (ALAS float*)(lds + (w & 3) * 16384);
        if (mapc == 1) {
#pragma unroll
            for (int d0 = 0; d0 < 4; ++d0)
#pragma unroll
                for (int r = 0; r < 16; ++r) st1[(d0 * 16 + r) * 64 + lane] = o[d0][r] * rl[r];
        }
        asm volatile("s_waitcnt lgkmcnt(0)" ::: "memory"); __builtin_amdgcn_s_barrier(); asm volatile("" ::: "memory");
        if (mapc == 0) {
            const float lam = WSP(float, WS_SC)[0]; float ss[16];
#pragma unroll
            for (int r = 0; r < 16; ++r) { float a = 0.f;
#pragma unroll
                for (int d0 = 0; d0 < 4; ++d0) { const float v = o[d0][r] * rl[r] - lam * st1[(d0 * 16 + r) * 64 + lane]; o[d0][r] = v; a += v * v; }
                ss[r] = a; }
#pragma unroll
            for (int r = 0; r < 16; ++r) { float a = ss[r]; a += __shfl_xor(a, 1); a += __shfl_xor(a, 2); a += __shfl_xor(a, 4); a += __shfl_xor(a, 8); a += __shfl_xor(a, 16);
                ss[r] = rsqrtf(a * (1.0f / 128.0f) + RMS_EPS) * (1.0f - LAMBDA_INIT); }
            ALAS bf16* st0 = (ALAS bf16*)(lds + 65536 + w * 8192);
#pragma unroll
            for (int d0 = 0; d0 < 4; ++d0) { const float sw = c.subln[d0 * 32 + r32];
#pragma unroll
                for (int r = 0; r < 16; ++r) st0[crow(r, hi) * 128 + d0 * 32 + r32] = (bf16)f2bf(o[d0][r] * ss[r] * sw); }
            asm volatile("s_waitcnt lgkmcnt(0)" ::: "memory");
#pragma unroll
            for (int i = 0; i < 8; ++i) { const int row = 4 * i + (lane >> 4), ch = lane & 15; const size_t gi = (tok0 + wrow + row) * 512 + h * 128 + ch * 8;
                f32x4 y0, y1, z0, z1; unpack8(*(const ALAS v4u*)(st0 + row * 128 + ch * 8), y0, y1); unpack8(*(const v4u*)(Zg + gi), z0, z1);
                *(v4u*)(Og + gi) = pack8(y0 * z0, y1 * z1); }
        }
    } else {
        ALAS bf16* st0 = (ALAS bf16*)(lds + w * 8192);
#pragma unroll
        for (int d0 = 0; d0 < 4; ++d0)
#pragma unroll
            for (int r = 0; r < 16; ++r) st0[crow(r, hi) * 128 + d0 * 32 + r32] = (bf16)f2bf(o[d0][r] * rl[r]);
        asm volatile("s_waitcnt lgkmcnt(0)" ::: "memory");
#pragma unroll
        for (int i = 0; i < 8; ++i) { const int row = 4 * i + (lane >> 4), ch = lane & 15; const size_t gi = (tok0 + wrow + row) * 512 + h * 128 + ch * 8;
            f32x4 y0, y1, z0, z1; unpack8(*(const ALAS v4u*)(st0 + row * 128 + ch * 8), y0, y1); unpack8(*(const v4u*)(Zg + gi), z0, z1);
            *(v4u*)(Og + gi) = pack8(y0 * z0, y1 * z1); }
    }
    asm volatile("s_waitcnt vmcnt(0) lgkmcnt(0)" ::: "memory"); __builtin_amdgcn_s_barrier(); asm volatile("" ::: "memory");
}
__device__ __forceinline__ void attn_phase(const Ctx& c, ALAS unsigned char* lds, int G, int cu) {
    const int vcu = (G % 8 == 0) ? (cu % 8) * (G / 8) + cu / 8 : cu;
    for (int u = vcu; u < 256; u += G) { const int bh = u >> 3, sx = u & 7;
        for (int i = 0; i < 4; ++i) { const int qb = (i == 0) ? sx : (i == 1) ? 15 - sx : (i == 2) ? 16 + sx : 31 - sx; attn_unit<true>(c, lds, bh >> 2, bh & 3, qb); } }
    for (int u = vcu; u < 512; u += G) attn_unit<false>(c, lds, u >> 6, (u >> 4) & 3, u & 15);
}
}

struct EpiP1 {
    unsigned char* ws;
    __device__ __forceinline__ void operator()(acc_t& acc, const pg8::GUnit& u, int wr, int wc, int fr, int fq) const {
        const int seg = u.pn >> 1;
        const int row0 = u.pm * 256 + wr * 64 + fr;
#pragma unroll
        for (int ai = 0; ai < 2; ++ai)
#pragma unroll
            for (int m = 0; m < 4; ++m) { const int row = row0 + ai * 128 + m * 16;
#pragma unroll
                for (int bj = 0; bj < 2; ++bj) { const int col8 = u.pn * 256 + bj * 128 + wc * 32 + 8 * fq; f32x4 v0 = acc[ai][bj][m][0], v1 = acc[ai][bj][m][1]; bf16* dst;
                    if (seg >= 8) { v0 = map4(v0, fast_sigmoid); v1 = map4(v1, fast_sigmoid); dst = (bf16*)(ws + WS_GT) + (size_t)row * 3072 + (col8 - 4096); }
                    else if (seg == 0) { const int cc = col8 & 511; dst = (bf16*)(ws + WS_UG) + ((((size_t)(cc >> 4) * NCOL + (row >> 6)) * 64 + (row & 63)) * 16 + (cc & 15)); }
                    else { if (seg == 1 || seg == 5 || seg == 7) { v0 = v0 * map4(v0, fast_sigmoid); v1 = v1 * map4(v1, fast_sigmoid); } else if (seg == 2) { v0 = v0 * QS_DIFF; v1 = v1 * QS_DIFF; } else if (seg == 6) { v0 = v0 * QS_MEM; v1 = v1 * QS_MEM; }
                        dst = (bf16*)(ws + WS_PROJ + (size_t)seg * SEGB) + (size_t)row * 512 + (col8 & 511); }
                    *(v4u*)dst = pack8(v0, v1); } }
    }
};
struct EpiMKV {
    bf16 *mk, *mv;
    __device__ __forceinline__ void operator()(acc_t& acc, const pg8::GUnit& u, int wr, int wc, int fr, int fq) const {
        const int row0 = u.pm * 256 + wr * 64 + fr; bf16* base = u.pn < 2 ? mk : mv;
#pragma unroll
        for (int ai = 0; ai < 2; ++ai)
#pragma unroll
            for (int m = 0; m < 4; ++m) { const int row = row0 + ai * 128 + m * 16;
#pragma unroll
                for (int bj = 0; bj < 2; ++bj) { const int col8 = (u.pn & 1) * 256 + bj * 128 + wc * 32 + 8 * fq; *(v4u*)(base + (size_t)row * 512 + col8) = pack8(acc[ai][bj][m][0], acc[ai][bj][m][1]); } }
    }
};
struct EpiGLU {
    const bf16* zs; bf16* ys;
    __device__ __forceinline__ void operator()(acc_t& acc, const pg8::GUnit& u, int wr, int wc, int fr, int fq) const {
        const int row0 = u.pm * 256 + wr * 64 + fr, ch8 = u.pn * 128 + wc * 32 + 8 * fq;
#pragma unroll
        for (int ai = 0; ai < 2; ++ai)
#pragma unroll
            for (int m = 0; m < 4; ++m) { const size_t off = (size_t)(row0 + ai * 128 + m * 16) * 512 + ch8; f32x4 z0, z1; unpack8(*(const v4u*)(zs + off), z0, z1);
                const f32x4 y0 = acc[ai][0][m][0] * map4(acc[ai][1][m][0], fast_sigmoid) * z0, y1 = acc[ai][0][m][1] * map4(acc[ai][1][m][1], fast_sigmoid) * z1;
                *(v4u*)(ys + off) = pack8(y0, y1); }
    }
};
struct EpiMerge {
    const bf16* gt; bf16* mg;
    __device__ __forceinline__ void operator()(acc_t& acc, const pg8::GUnit& u, int wr, int wc, int fr, int fq) const {
        const int row0 = u.pm * 256 + wr * 64 + fr, s = u.seg;
#pragma unroll
        for (int ai = 0; ai < 2; ++ai)
#pragma unroll
            for (int m = 0; m < 4; ++m) { const int row = row0 + ai * 128 + m * 16;
#pragma unroll
                for (int bj = 0; bj < 2; ++bj) { const int col8 = u.pn * 256 + bj * 128 + wc * 32 + 8 * fq; const bf16* gp = gt + (size_t)row * 3072 + s * 1024 + col8;
                    f32x4 a0, a1; unpack8(*(const v4u*)gp, a0, a1);
                    if (s < 2) { f32x4 b0, b1; unpack8(*(const v4u*)(gp + 1024), b0, b1);
                        auto rc = [](float x) { return __builtin_amdgcn_rcpf(fmaxf(x, 1e-30f)); };
                        acc[ai][bj][m][0] = acc[ai][bj][m][0] * (a0 * map4(b0, rc)); acc[ai][bj][m][1] = acc[ai][bj][m][1] * (a1 * map4(b1, rc)); }
                    else *(v4u*)(mg + (size_t)row * 1024 + col8) = pack8(acc[ai][bj][m][0] * a0, acc[ai][bj][m][1] * a1); } }
    }
};
struct EpiOut {
    const float* x; float* out;
    __device__ __forceinline__ void operator()(acc_t& acc, const pg8::GUnit& u, int wr, int wc, int fr, int fq) const {
        const int row0 = u.pm * 256 + wr * 64 + fr, col0 = u.pn * 256 + wc * 32 + 4 * fq;
#pragma unroll
        for (int ai = 0; ai < 2; ++ai)
#pragma unroll
            for (int m = 0; m < 4; ++m) { const size_t off = (size_t)(row0 + ai * 128 + m * 16) * 1024 + col0;
#pragma unroll
                for (int bj = 0; bj < 2; ++bj)
#pragma unroll
                    for (int n = 0; n < 2; ++n) { const f32x4 xv = *(const f32x4*)(x + off + bj * 128 + n * 16); *(f32x4*)(out + off + bj * 128 + n * 16) = xv * ALPHA + acc[ai][bj][m][n]; } }
    }
};

struct EpiF {
    float* F;
    __device__ __forceinline__ void operator()(acc_t& acc, const pg8::GUnit& u, int wr, int wc, int fr, int fq) const {
        const int row0 = u.pm * 256 + wr * 64 + fr, col0 = wc * 32 + 4 * fq; float* base = F + (size_t)u.aux * NCOL * 128;
#pragma unroll
        for (int ai = 0; ai < 2; ++ai)
#pragma unroll
            for (int m = 0; m < 4; ++m)
#pragma unroll
                for (int n = 0; n < 2; ++n) *(f32x4*)(base + (size_t)(row0 + ai * 128 + m * 16) * 128 + col0 + n * 16) = acc[ai][0][m][n];
    }
};
struct SchedF {
    const char* UG; const char* WG; int G, c;
    __device__ __forceinline__ bool next(int i, pg8::GUnit& u) const { const int idx = i * G + c; if (idx >= 64) return false; const int g = idx >> 1, pm = idx & 1;
        u.A = UG + ((size_t)g * NCOL + pm * 256) * 1024 * 2; u.B = WG + (size_t)g * 128 * 1024 * 2; u.nt = 16; u.pm = pm; u.pn = 0; u.seg = 0; u.last = 1; u.cfg = 0; u.aux = g; return true; }
};
struct EpiS5Y {
    const bf16* UG; const float* dskip; bf16* VB;
    __device__ __forceinline__ void operator()(acc_t& acc, const pg8::GUnit& u, int wr, int wc, int fr, int fq) const {
        if (!u.last) return;
        const int g = u.aux, row0 = u.pm * 256 + wr * 64 + fr;
#pragma unroll
        for (int bj = 0; bj < 2; ++bj) { const int n8 = u.pn * 256 + bj * 128 + wc * 32 + 8 * fq, i = n8 >> 4, h0 = n8 & 15;
            const f32x4 d0 = *(const f32x4*)(dskip + g * 16 + h0), d1 = *(const f32x4*)(dskip + g * 16 + h0 + 4);
#pragma unroll
            for (int ai = 0; ai < 2; ++ai)
#pragma unroll
                for (int m = 0; m < 4; ++m) { const int r = row0 + ai * 128 + m * 16; f32x4 u0, u1; unpack8(*(const v4u*)(UG + ((size_t)g * NCOL + r) * 1024 + n8), u0, u1);
                    auto ge = [](float v) { const float t = 0.7978845608028654f * (v + 0.044715f * v * v * v); return v * __builtin_amdgcn_rcpf(1.0f + __builtin_amdgcn_exp2f(-2.0f * LOG2E * t)); };
                    const f32x4 y0 = map4(acc[ai][bj][m][0] + d0 * u0, ge), y1 = map4(acc[ai][bj][m][1] + d1 * u1, ge);
                    *(v4u*)(VB + ((size_t)r * 64 + i) * 512 + g * 16 + h0) = pack8(y0, y1); } }
    }
};
struct SchedS5Y {
    const char* UG; const char* TGC; const char* HH; const char* GG; int G, c, dup;
    __device__ __forceinline__ bool next(int i, pg8::GUnit& u) const { const int idx = ((i >> 1) / dup) * G + c, s = i & 1; if (idx >= 256) return false; const int g = idx >> 3, pm = (idx >> 2) & 1, pn = 3 - (idx & 3);
        u.pm = pm; u.pn = pn; u.seg = s; u.last = s; u.cfg = s; u.aux = g;
        if (s == 0) { u.A = UG + ((size_t)g * NCOL + pm * 256) * 1024 * 2; u.B = TGC + (size_t)g * 16 * 127 * 16 * 2 - 512 * pn; u.nt = 4 * (pn + 1); }
        else { u.A = HH + ((size_t)g * NCOL + pm * 256) * 256 * 2; u.B = GG + ((size_t)g * 1024 + pn * 256) * 128 * 2; u.nt = 4; }
        return true; }
};
__device__ __forceinline__ void s5_scan(const Ctx& c, int gt, int ngt) {
    const float* F = DOP(float, DO_F); bf16* HH = DOP(bf16, DO_HH); const float* LP = WSP(float, WS_LP);
    for (int idx = gt; idx < NG * NB * NP; idx += ngt) {
        const int p = idx & 63, b = (idx >> 6) & 7, g = idx >> 9; const float ar = LP[(g * NP + p) * 2], ai = LP[(g * NP + p) * 2 + 1];
        float hr = 0.f, hi = 0.f; const float* f = F + ((size_t)g * NCOL + b * 64) * 128 + p; bf16* hh = HH + ((size_t)g * NCOL + b * 64) * 256 + p;
#pragma unroll 16
        for (int n = 0; n < 64; ++n) { hh[n * 256] = (bf16)f2bf(hr); hh[n * 256 + 64] = (bf16)f2bf(hi); hh[n * 256 + 128] = 0; hh[n * 256 + 192] = 0;
            const float fr = f[n * 128], fi = f[n * 128 + 64]; const float nr = ar * hr - ai * hi + fr, ni = ar * hi + ai * hr + fi; hr = nr; hi = ni; }
    }
}
struct SchedPlain {
    const char* A; const char* B; int nM, nN, G, c, nt; size_t tA, tB; int dup;
    __device__ __forceinline__ bool next(int i, pg8::GUnit& u) const { int pm, pn; if (!pg8::tile_order(nM, nN, G, c, i / dup, pm, pn)) return false;
        u.A = A + (size_t)pm * tA; u.B = B + (size_t)pn * tB; u.nt = nt; u.pm = pm; u.pn = pn; u.seg = 0; u.last = 1; u.cfg = 0; u.aux = 0; return true; }
};
struct SchedMerge {
    const char* A0; const char* A1; const char* A2; const char* B; int G, c, dup;
    __device__ __forceinline__ bool next(int i, pg8::GUnit& u) const { int pm, pn; const int s = i % 3; if (!pg8::tile_order(128, 4, G, c, (i / 3) / dup, pm, pn)) return false;
        u.A = (s == 0 ? A0 : (s == 1 ? A1 : A2)) + (size_t)pm * 256 * 512 * 2; u.B = B + ((size_t)pn * 256 * 1536 + 512 * s) * 2; u.nt = 8; u.pm = pm; u.pn = pn; u.seg = s; u.last = (s == 2); u.cfg = 0; u.aux = 0; return true; }
};


#define XB_TMO      128
#define XB_XCNT(j)  (256  + 64 * (j))
#define XB_XSUB(j)  (1280 + 64 * (j))
#define XB_XGEN(j)  (2304 + 64 * (j))
#define XB_TOP      3328
#define XB_TOPGEN   3392
#define XCD_BAR_WORDS 3456
#define XB_SPIN_CAP (1u << 18)
#define LAS3 __attribute__((address_space(3)))
__device__ __forceinline__ unsigned xb_ld(unsigned* p)              { return __hip_atomic_load(p, __ATOMIC_RELAXED, __HIP_MEMORY_SCOPE_AGENT); }
__device__ __forceinline__ unsigned xb_add(unsigned* p, unsigned v) { return __hip_atomic_fetch_add(p, v, __ATOMIC_RELAXED, __HIP_MEMORY_SCOPE_AGENT); }
__device__ __forceinline__ unsigned xb_xcc_id() { return (unsigned)__builtin_amdgcn_s_getreg((3 << 11) | 20) & 0xFu; }
#define XB_SPIN(cond, bar) do { unsigned _sp = 0; while (cond) { __builtin_amdgcn_s_sleep(1); \
    if ((++_sp & 255u) == 0u) { if (xb_ld(&(bar)[XB_TMO])) break; if (_sp > XB_SPIN_CAP) { atomicAdd(&(bar)[XB_TMO], 1u); break; } } } } while (0)
struct XcdBarrier { unsigned* bar; unsigned x; volatile LAS3 unsigned* st; };
__device__ __forceinline__ XcdBarrier xcd_barrier_post(unsigned* bar, volatile LAS3 unsigned* st) {
    XcdBarrier b; b.bar = bar; b.x = xb_xcc_id(); b.st = st;
    if (threadIdx.x == 0) (void)xb_add(&bar[XB_XCNT(b.x)], 1u);
    return b;
}
__device__ __forceinline__ void xcd_barrier_complete(unsigned* bar, unsigned x, unsigned& nloc, unsigned& nx) {
    const unsigned G = gridDim.x * gridDim.y * gridDim.z;
    unsigned sum, cnt, mine, sp = 0u;
    for (;;) {
        sum = 0u; cnt = 0u; mine = 0u;
#pragma unroll
        for (unsigned j = 0; j < 16; ++j) { const unsigned c = xb_ld(&bar[XB_XCNT(j)]); sum += c; cnt += (c > 0u) ? 1u : 0u; mine = (j == x) ? c : mine; }
        if (sum == G) break;
        __builtin_amdgcn_s_sleep(1);
        if ((++sp & 255u) == 0u) { if (xb_ld(&bar[XB_TMO])) break; if (sp > XB_SPIN_CAP) { atomicAdd(&bar[XB_TMO], 1u); break; } }
    }
    nloc = mine > 0u ? mine : 1u; nx = cnt > 0u ? cnt : 1u;
}
__device__ __forceinline__ void xcd_barrier(const XcdBarrier& b) {
    asm volatile("s_waitcnt vmcnt(0)" ::: "memory");
    __syncthreads();
    if (threadIdx.x == 0) {
        unsigned* bar = b.bar;
        __builtin_amdgcn_s_waitcnt(0);
        unsigned nloc = b.st[0], nx = b.st[1];
        if (nloc == 0u) { xcd_barrier_complete(bar, b.x, nloc, nx); b.st[0] = nloc; b.st[1] = nx; }
        const unsigned old = xb_add(&bar[XB_XSUB(b.x)], 1u);
        const unsigned gen = old / nloc;
        if (old + 1u == (gen + 1u) * nloc) {
            __builtin_amdgcn_fence(__ATOMIC_RELEASE, "agent");
            asm volatile("s_waitcnt vmcnt(0)" ::: "memory");
            const unsigned og = xb_add(&bar[XB_TOP], 1u);
            const unsigned tg = og / nx;
            if (og + 1u == (tg + 1u) * nx) xb_add(&bar[XB_TOPGEN], 1u);
            else XB_SPIN(xb_ld(&bar[XB_TOPGEN]) == tg, bar);
            __builtin_amdgcn_fence(__ATOMIC_ACQUIRE, "agent");
            xb_add(&bar[XB_XGEN(b.x)], 1u);
            asm volatile("s_waitcnt vmcnt(0)" ::: "memory");
        } else {
            XB_SPIN(xb_ld(&bar[XB_XGEN(b.x)]) == gen, bar);
            __builtin_amdgcn_fence(__ATOMIC_ACQUIRE, "agent");
            asm volatile("s_waitcnt vmcnt(0)" ::: "memory");
        }
    }
    __syncthreads();
}

constexpr int MK_LDS = 147456;
enum { PH_P0 = 0, PH_PROJ = 1, PH_MIX = 2, PH_SCAN = 3, PH_S5Y = 4, PH_GLU = 5, PH_MERGE = 6, PH_OUT = 7, PH_LN = 8, PH_N = 9 };
__global__ void __launch_bounds__(512, 2) mk_fwd(Ctx c) {
    extern __shared__ __attribute__((aligned(16))) unsigned char lds[];
    PG8_LAS unsigned char* L3 = (PG8_LAS unsigned char*)lds;
    const int G = gridDim.x, cu = blockIdx.x;
    const int lane = threadIdx.x & 63, wave = __builtin_amdgcn_readfirstlane(threadIdx.x >> 6);
    XcdBarrier gbar; gbar.bar = (unsigned*)(c.ws + WS_CTL + 4096); gbar.x = 0; gbar.st = (volatile LAS3 unsigned*)(L3 + 131072 + 320);
    if (c.coop) { if (threadIdx.x < 64) ((LAS3 unsigned*)(L3 + 131072))[threadIdx.x + 64] = 0u; __syncthreads(); gbar = xcd_barrier_post(gbar.bar, gbar.st); }
#define IN(k) (c.ph_lo <= (k) && (k) < c.ph_hi)
#define REPEAT(k) for (int rep_ = 0; rep_ <= ((REP_MASK >> (k)) & 1); ++rep_) if (rep_ == 0 || (xcd_barrier(gbar), true))
#define SEAM(k) do { if (c.coop && IN(k) && IN((k) + 1)) xcd_barrier(gbar); } while (0)
    if (IN(PH_P0)) REPEAT(PH_P0) p0_prologue(c, cu * 8 + wave, G * 8, lane, (float*)(lds + wave * 16384));
    SEAM(PH_P0);
    for (int e_ = 0; e_ < EXTRA_SYNCS; ++e_) xcd_barrier(gbar);
    if (IN(PH_PROJ)) REPEAT(PH_PROJ) {
        { pg8::LoadCfg L; pg8::voff_plain(L.voffA[0], 1024, false); pg8::voff_plain(L.voffB[0], 1024, true); L.hsA[0] = 128 * 1024 * 2; L.hsB[0] = 128 * 1024 * 2;
          SchedPlain S{(const char*)DOP(bf16, DO_XB), (const char*)WSP(bf16, WS_WINT), 128, 28, G, cu, 16, (size_t)256 * 1024 * 2, (size_t)256 * 1024 * 2, DUP_PROJ};
          EpiP1 E{c.ws}; pg8::gemm_phase<EpiP1, SchedPlain, true, true>(L3, L, S, E); }
        { pg8::LoadCfg L; pg8::voff_plain(L.voffA[0], 1024, false); pg8::voff_plain(L.voffB[0], 1024, true); L.hsA[0] = 128 * 1024 * 2; L.hsB[0] = 128 * 1024 * 2;
          SchedPlain S{(const char*)DOP(bf16, DO_MEMB), (const char*)WSP(bf16, WS_WMKVT), 8, 4, G, cu, 16, (size_t)256 * 1024 * 2, (size_t)256 * 1024 * 2, 1};
          EpiMKV E{DOP(bf16, DO_MK), DOP(bf16, DO_MV)}; pg8::gemm_phase<EpiMKV, SchedPlain, true, true>(L3, L, S, E); }
    }
    SEAM(PH_PROJ);
    if (IN(PH_MIX)) REPEAT(PH_MIX) {
#if !USE_NAIVE_ATTN
        att::attn_phase(c, L3, G, cu);
#endif
        pg8::LoadCfg L; pg8::voff_plain(L.voffA[0], 1024, false); pg8::voff_plain(L.voffB[0], 1024, false); L.hsA[0] = 128 * 1024 * 2; L.hsB[0] = 0;
        SchedF S{(const char*)WSP(bf16, WS_UG), (const char*)DOP(bf16, DO_WG), G, cu};
        EpiF E{DOP(float, DO_F)}; pg8::gemm_phase<EpiF, SchedF, true, true>(L3, L, S, E);
    }
    SEAM(PH_MIX);
    if (IN(PH_SCAN)) REPEAT(PH_SCAN) s5_scan(c, cu * 512 + threadIdx.x, G * 512);
    SEAM(PH_SCAN);
    if (IN(PH_S5Y)) REPEAT(PH_S5Y) {
        pg8::LoadCfg L; pg8::voff_plain(L.voffA[0], 1024, false); pg8::voff_plain(L.voffA[1], 256, false); pg8::voff_plain(L.voffB[1], 128, true);
        L.hsA[0] = 128 * 1024 * 2; L.hsA[1] = 128 * 256 * 2; L.hsB[0] = -256; L.hsB[1] = 128 * 128 * 2;
#pragma unroll
        for (int i = 0; i < 2; ++i) { int R, C; pg8::stage_rc(threadIdx.x * 16 + i * 8192, R, C); const int Rb = (R & ~31) + pg8::perm32(R & 31);
            L.voffB[0][i] = (unsigned)((Rb & 15) * 127 * 16 + (63 - (Rb >> 4)) * 16 + C) * 2u; }
        SchedS5Y S{(const char*)WSP(bf16, WS_UG), (const char*)DOP(bf16, DO_TGC), (const char*)DOP(bf16, DO_HH), (const char*)DOP(bf16, DO_GG), G, cu, DUP_S5Y};
        EpiS5Y E{WSP(bf16, WS_UG), c.d_skip, DOP(bf16, DO_VB)}; pg8::gemm_phase<EpiS5Y, SchedS5Y, true, true, 2>(L3, L, S, E);
    }
    SEAM(PH_S5Y);
    if (IN(PH_GLU)) REPEAT(PH_GLU) {
        pg8::LoadCfg L; pg8::voff_plain(L.voffA[0], 512, false); pg8::voff_plain(L.voffB[0], 512, true); L.hsA[0] = 128 * 512 * 2; L.hsB[0] = 128 * 512 * 2;
        SchedPlain S{(const char*)DOP(bf16, DO_VB), (const char*)WSP(bf16, WS_WGLUT), 128, 4, G, cu, 8, (size_t)256 * 512 * 2, (size_t)256 * 512 * 2, DUP_GLU};
        EpiGLU E{WSP(bf16, WS_ZS), WSP(bf16, WS_YS)}; pg8::gemm_phase<EpiGLU, SchedPlain, true, true>(L3, L, S, E);
    }
    SEAM(PH_GLU);
    if (IN(PH_MERGE)) REPEAT(PH_MERGE) {
        pg8::LoadCfg L; pg8::voff_plain(L.voffA[0], 512, false); pg8::voff_plain(L.voffB[0], 1536, true); L.hsA[0] = 128 * 512 * 2; L.hsB[0] = 128 * 1536 * 2;
        SchedMerge S{(const char*)WSP(bf16, WS_YS), (const char*)WSP(bf16, WS_YD), (const char*)DOP(bf16, DO_YM), (const char*)WSP(bf16, WS_WBRT), G, cu, DUP_MERGE};
        EpiMerge E{WSP(bf16, WS_GT), WSP(bf16, WS_MG)}; pg8::gemm_phase<EpiMerge, SchedMerge, true, true>(L3, L, S, E);
    }
    SEAM(PH_MERGE);
    if (IN(PH_OUT)) REPEAT(PH_OUT) {
        pg8::LoadCfg L; pg8::voff_plain(L.voffA[0], 1024, false); pg8::voff_plain(L.voffB[0], 1024, false); L.hsA[0] = 128 * 1024 * 2; L.hsB[0] = 128 * 1024 * 2;
        SchedPlain S{(const char*)WSP(bf16, WS_MG), (const char*)WSP(bf16, WS_WOUTT), 128, 4, G, cu, 16, (size_t)256 * 1024 * 2, (size_t)256 * 1024 * 2, DUP_OUT};
        EpiOut E{c.x, c.out}; pg8::gemm_phase<EpiOut, SchedPlain, true, true>(L3, L, S, E);
    }
    SEAM(PH_OUT);
    if (IN(PH_LN)) { if (LN_DRY) { ln_rows(c, cu * 8 + wave, G * 8, lane, WSP(float, WS_PROJ + 8 * SEGB)); xcd_barrier(gbar); }
        ln_rows(c, cu * 8 + wave, G * 8, lane, c.out); }
#undef IN
#undef SEAM
#undef REPEAT
}

extern "C" void kernel_launch(void* const* d_in, const int* in_sizes, int n_in, void* d_out, int out_size, void* d_ws, size_t ws_size, hipStream_t stream) {
    static int ok = 0, grid = 0;
    if (ok == 0) {
        if (n_in != 25 || in_sizes[0] != T * DM || out_size != T * DM || ws_size < WS_END) { fprintf(stderr, "kernel_launch: unexpected shapes (n_in %d, in0 %d, out %d, ws %zu)\n", n_in, in_sizes[0], out_size, ws_size); ok = -1; return; }
        (void)hipFuncSetAttribute((const void*)mk_fwd, hipFuncAttributeMaxDynamicSharedMemorySize, MK_LDS);
        (void)hipFuncSetAttribute((const void*)nk_attn<true>, hipFuncAttributeMaxDynamicSharedMemorySize, 98304);
        (void)hipFuncSetAttribute((const void*)nk_attn<false>, hipFuncAttributeMaxDynamicSharedMemorySize, 98304);
        int dev = 0, cus = 0, per_cu = 0;
        (void)hipGetDevice(&dev); (void)hipDeviceGetAttribute(&cus, hipDeviceAttributeMultiprocessorCount, dev);
        (void)hipOccupancyMaxActiveBlocksPerMultiprocessor(&per_cu, (const void*)mk_fwd, 512, MK_LDS);
        if (per_cu < 1) { fprintf(stderr, "kernel_launch: occupancy query reports %d blocks per CU; nothing launched\n", per_cu); ok = -1; return; }
        grid = cus;
        ok = 1;
    }
    if (ok < 0) return;
    Ctx c{};
    const float** f = (const float**)&c.x;
    for (int i = 0; i < 25; ++i) f[i] = (const float*)d_in[i];
    c.out = (float*)d_out; c.ws = (unsigned char*)d_ws; c.ph_lo = 0; c.ph_hi = 0;
#if ONE_LAUNCH
    c.ph_lo = 0; c.ph_hi = PH_N; c.coop = 1;
    if (hipMemsetAsync((char*)d_ws + WS_CTL, 0, 65536, stream) != hipSuccess) { fprintf(stderr, "kernel_launch: memset of the control words failed\n"); return; }
    hipLaunchKernelGGL(mk_fwd, dim3(grid), dim3(512), MK_LDS, stream, c);
#else
    auto run = [&](int lo, int hi) { c.ph_lo = lo; c.ph_hi = hi; c.coop = 0; hipLaunchKernelGGL(mk_fwd, dim3(256), dim3(512), MK_LDS, stream, c); };
    run(PH_P0, PH_P0 + 1);
    run(PH_PROJ, PH_PROJ + 1);
#if USE_NAIVE_ATTN
    hipLaunchKernelGGL(nk_attn<true>, dim3(NB * 4 * 64), dim3(256), 83968, stream, c);
    hipLaunchKernelGGL(nk_attn<false>, dim3(NB * 4 * 64), dim3(256), 83968, stream, c);
#endif
#if USE_NAIVE_S5
    hipLaunchKernelGGL(nk_s5, dim3(NB * NG), dim3(64), 0, stream, c);
#else
    run(PH_MIX, PH_MIX + 1); run(PH_SCAN, PH_SCAN + 1); run(PH_S5Y, PH_S5Y + 1);
#endif
    run(PH_GLU, PH_GLU + 1);
    run(PH_MERGE, PH_MERGE + 1);
    run(PH_OUT, PH_OUT + 1);
    run(PH_LN, PH_LN + 1);
#endif
}
```
